# Optimizing an MI355X kernel written in HIP

```python
import math
import jax, jax.numpy as jnp
from jax import lax
import numpy as np

D_MODEL = 1024
BATCH = 4
SEQ = 8192
DEPTH = 1
DEC_BATCH = 16
DEC_SEQ = 16
PAST_LEN = 1024

CHUNK = 64
N_META = 16
PREFIX = 128
Q_BLOCK = 128
RET_HEADS = 4
RET_DK = D_MODEL // 8
RET_DV = 2 * RET_DK
RET_QK_W = RET_HEADS * RET_DK
RET_V_W = RET_HEADS * RET_DV
ROPE_BASE = 10000.0
RET_EPS = 1e-6
DIFF_HEADS = 8
DIFF_DH = D_MODEL // 16
DIFF_DV = 2 * DIFF_DH
DIFF_W = DIFF_HEADS * DIFF_DV
DIFF_EPS = 1e-5
N_BUCKETS = 32
MAX_DISTANCE = 128
D_FF = ((8 * D_MODEL + 3 * 256 - 1) // (3 * 256)) * 256
NORM_EPS = 1e-6
NEG_INF = -1e30
IN_WIDTHS = (RET_QK_W, RET_QK_W, RET_V_W, RET_V_W,
             DIFF_HEADS * 2 * DIFF_DH, DIFF_HEADS * 2 * DIFF_DH, DIFF_W,
             D_MODEL, D_MODEL)
W_IN = sum(IN_WIDTHS)

kernel_name = 'hybrid_retention_diffattn_stream'


def rmsnorm(x, g=None, eps=NORM_EPS):
    xf = x.astype(jnp.float32)
    y = xf * lax.rsqrt(jnp.mean(xf * xf, axis=-1, keepdims=True) + eps)
    if g is not None:
        y = y * g.astype(jnp.float32)
    return y.astype(x.dtype)


def in_proj(xn, w_in):
    offsets = np.cumsum(IN_WIDTHS)[:-1].tolist()
    return jnp.split(xn @ w_in, offsets, axis=-1)


def rotary(x, pos):
    half = x.shape[-1] // 2
    freq = 1.0 / (ROPE_BASE ** jnp.linspace(0.0, 1.0, half, dtype=jnp.float32))
    ang = pos.astype(jnp.float32)[:, None] * freq[None, :]
    cos = jnp.cos(ang)[None, :, None, :]
    sin = jnp.sin(ang)[None, :, None, :]
    x1, x2 = x[..., :half], x[..., half:]
    return jnp.concatenate([x1 * cos - x2 * sin, x1 * sin + x2 * cos], axis=-1).astype(x.dtype)


def retention_log_decay():
    return jnp.log(1.0 - 2.0 ** (-5.0 - jnp.arange(RET_HEADS, dtype=jnp.float32)))


def retention_chunk(S, q, k, v):
    L = q.shape[1]
    lg = retention_log_decay()
    i = jnp.arange(L, dtype=jnp.float32)
    qf, kf, vf, Sf = (t.astype(jnp.float32) for t in (q, k, v, S))
    decay_in = jnp.exp(lg[:, None, None] * jnp.abs(i[:, None] - i[None, :]))
    s = jnp.einsum('blhd,bmhd->bhlm', qf, kf) * decay_in[None]
    o = jnp.einsum('bhlm,bmhe->blhe', s, vf)
    q_dec = jnp.exp(lg[None, :] * (i[:, None] + 1.0))
    o = o + jnp.einsum('blhd,bhde->blhe', qf * q_dec[None, :, :, None], Sf)
    k_dec = jnp.exp(lg[None, :] * (L - 1.0 - i)[:, None])
    S_new = jnp.exp(lg * L)[None, :, None, None] * Sf + jnp.einsum('bmhd,bmhe->bhde', kf * k_dec[None, :, :, None], vf)
    return o.astype(q.dtype), S_new.astype(S.dtype)


def t5_bucket(rel):
    nb = N_BUCKETS // 2
    max_exact = nb // 2
    ret = jnp.where(rel > 0, nb, 0)
    n = jnp.abs(rel)
    nf = jnp.maximum(n, max_exact).astype(jnp.float32)
    large = max_exact + (jnp.log(nf / max_exact) / math.log(MAX_DISTANCE / max_exact) * (nb - max_exact)).astype(jnp.int32)
    large = jnp.minimum(large, nb - 1)
    return ret + jnp.where(n < max_exact, n, large)


def diff_lambda(lq1, lk1, lq2, lk2, lam_init):
    f = lambda a, b: jnp.exp(jnp.sum(a.astype(jnp.float32) * b.astype(jnp.float32)))
    return f(lq1, lk1) - f(lq2, lk2) + lam_init


def diff_softmax_mix(q, k, v, bias, mask, lam):
    s = jnp.einsum('bqhcd,bkhcd->bchqk', q, k).astype(jnp.float32) * (DIFF_DH ** -0.5) + bias.astype(jnp.float32)
    s = jnp.where(mask, s, NEG_INF)
    p = jax.nn.softmax(s, axis=-1)
    a = p[:, 0] - lam * p[:, 1]
    return jnp.einsum('bhqk,bkhe->bqhe', a.astype(v.dtype), v)


def layer_tail(h, o_ret, rg, o_diff, gr, gd, lam_init, lw):
    (_, _, _, _, _, _, subg, w_rb, w_db, w_o, n2, w_up, w_down) = lw
    B, L, _ = h.shape
    y_ret = (rmsnorm(o_ret, None, RET_EPS) * jax.nn.silu(rg.reshape(B, L, RET_HEADS, RET_DV))).reshape(B, L, RET_V_W)
    y_diff = (rmsnorm(o_diff, subg, DIFF_EPS) * (1.0 - lam_init)).reshape(B, L, DIFF_W)
    merged = jax.nn.sigmoid(gr) * (y_ret @ w_rb) + jax.nn.sigmoid(gd) * (y_diff @ w_db)
    h = h + merged @ w_o
    gate, up = jnp.split(rmsnorm(h, n2) @ w_up, 2, axis=-1)
    return h + (jax.nn.silu(gate) * up) @ w_down


def prompt_layer(h, lw, lam_init, rel_bias):
    (n1, w_in, lq1, lk1, lq2, lk2) = lw[:6]
    B, LT, _ = h.shape
    xn = rmsnorm(h, n1)
    rq, rk, rv, rg, dq, dk, dv, gr, gd = in_proj(xn, w_in)
    idx = jnp.arange(LT)
    pos = idx - PREFIX
    valid = idx >= PREFIX - N_META
    q = rotary(rq.reshape(B, LT, RET_HEADS, RET_DK), pos) * (RET_DK ** -0.5)
    k = rotary(rk.reshape(B, LT, RET_HEADS, RET_DK), pos) * valid[None, :, None, None].astype(h.dtype)
    v = rv.reshape(B, LT, RET_HEADS, RET_DV)
    nc = LT // CHUNK
    chunks = lambda t: jnp.moveaxis(t.reshape((B, nc, CHUNK) + t.shape[2:]), 1, 0)

    def ret_step(S, qkv):
        o, S = retention_chunk(S, *qkv)
        return S, o

    S0 = jnp.zeros((B, RET_HEADS, RET_DK, RET_DV), h.dtype)
    S_fin, o_ret = lax.scan(ret_step, S0, (chunks(q), chunks(k), chunks(v)))
    o_ret = jnp.moveaxis(o_ret, 0, 1).reshape(B, LT, RET_HEADS, RET_DV)
    lam = diff_lambda(lq1, lk1, lq2, lk2, lam_init)
    qd = dq.reshape(B, LT, DIFF_HEADS, 2, DIFF_DH)
    kd = dk.reshape(B, LT, DIFF_HEADS, 2, DIFF_DH)
    vd = dv.reshape(B, LT, DIFF_HEADS, DIFF_DV)
    kchunk = jnp.floor_divide(pos, CHUNK)

    def attn_block(bi):
        start = bi * Q_BLOCK
        qb = lax.dynamic_slice_in_dim(qd, start, Q_BLOCK, axis=1)
        qpos = start + jnp.arange(Q_BLOCK) - PREFIX
        mask = (kchunk[None, :] <= jnp.floor_divide(qpos, CHUNK)[:, None]) & valid[None, :]
        bias = rel_bias.T[:, t5_bucket(pos[None, :] - qpos[:, None])]
        return diff_softmax_mix(qb, kd, vd, bias, mask, lam)

    o_diff = lax.map(attn_block, jnp.arange(LT // Q_BLOCK))
    o_diff = jnp.moveaxis(o_diff, 0, 1).reshape(B, LT, DIFF_HEADS, DIFF_DV)
    h = layer_tail(h, o_ret, rg, o_diff, gr, gd, lam_init, lw)
    keep = PREFIX - N_META
    k_rows = dk[:, keep:].reshape(B, LT - keep, DIFF_HEADS, 2 * DIFF_DH)
    v_rows = vd[:, keep:]
    return h, k_rows, v_rows, S_fin


def sample_layer(h, k_cache, v_cache, S, lw, lam_init, rel_bias):
    (n1, w_in, lq1, lk1, lq2, lk2) = lw[:6]
    B, L, _ = h.shape
    P = k_cache.shape[1]
    xn = rmsnorm(h, n1)
    rq, rk, rv, rg, dq, dk, dv, gr, gd = in_proj(xn, w_in)
    pos = P + jnp.arange(L)
    q = rotary(rq.reshape(B, L, RET_HEADS, RET_DK), pos) * (RET_DK ** -0.5)
    k = rotary(rk.reshape(B, L, RET_HEADS, RET_DK), pos)
    v = rv.reshape(B, L, RET_HEADS, RET_DV)
    o_ret, S_new = retention_chunk(S, q, k, v)
    lam = diff_lambda(lq1, lk1, lq2, lk2, lam_init)
    qd = dq.reshape(B, L, DIFF_HEADS, 2, DIFF_DH)
    kd = dk.reshape(B, L, DIFF_HEADS, 2, DIFF_DH)
    vd = dv.reshape(B, L, DIFF_HEADS, DIFF_DV)
    k_all = jnp.concatenate([k_cache.reshape(B, P, DIFF_HEADS, 2, DIFF_DH), kd], axis=1)
    v_all = jnp.concatenate([v_cache, vd], axis=1)
    kpos = jnp.arange(P + L)
    mask = jnp.floor_divide(kpos, CHUNK)[None, :] <= jnp.floor_divide(pos, CHUNK)[:, None]
    bias = rel_bias.T[:, t5_bucket(kpos[None, :] - pos[:, None])]
    o_diff = diff_softmax_mix(qd, k_all, v_all, bias, mask, lam)
    h = layer_tail(h, o_ret, rg, o_diff, gr, gd, lam_init, lw)
    return h, dk.reshape(B, L, DIFF_HEADS, 2 * DIFF_DH), vd, S_new


def setup_inputs(seed: int = 0) -> dict:
    key = jax.random.key(seed)
    ks = jax.random.split(key, 21)
    nrm = lambda k, shape, s: jax.random.normal(k, shape, jnp.float32) * s
    return {
        'x_prompt': nrm(ks[0], (BATCH, SEQ, D_MODEL), 1.0),
        'x_sample': nrm(ks[1], (DEC_BATCH, DEC_SEQ, D_MODEL), 1.0),
        'cache_k': nrm(ks[2], (DEPTH, DEC_BATCH, PAST_LEN, DIFF_HEADS, 2 * DIFF_DH), 1.0),
        'cache_v': nrm(ks[3], (DEPTH, DEC_BATCH, PAST_LEN, DIFF_HEADS, DIFF_DV), 1.0),
        'state_ret': nrm(ks[4], (DEPTH, DEC_BATCH, RET_HEADS, RET_DK, RET_DV), 4.0),
        'meta_tokens': nrm(ks[5], (N_META, D_MODEL), 1.0),
        'rel_bias': nrm(ks[6], (N_BUCKETS, DIFF_HEADS), 0.5),
        'norm1_g': 1.0 + nrm(ks[7], (DEPTH, D_MODEL), 0.02),
        'w_in': nrm(ks[8], (DEPTH, D_MODEL, W_IN), D_MODEL ** -0.5),
        'lambda_q1': nrm(ks[9], (DEPTH, DIFF_DH), 0.1),
        'lambda_k1': nrm(ks[10], (DEPTH, DIFF_DH), 0.1),
        'lambda_q2': nrm(ks[11], (DEPTH, DIFF_DH), 0.1),
        'lambda_k2': nrm(ks[12], (DEPTH, DIFF_DH), 0.1),
        'diff_subln_g': 1.0 + nrm(ks[13], (DEPTH, DIFF_DV), 0.02),
        'w_ret_branch': nrm(ks[14], (DEPTH, RET_V_W, D_MODEL), RET_V_W ** -0.5),
        'w_diff_branch': nrm(ks[15], (DEPTH, DIFF_W, D_MODEL), DIFF_W ** -0.5),
        'w_o': nrm(ks[16], (DEPTH, D_MODEL, D_MODEL), D_MODEL ** -0.5),
        'norm2_g': 1.0 + nrm(ks[17], (DEPTH, D_MODEL), 0.02),
        'w_ffn_up': nrm(ks[18], (DEPTH, D_MODEL, 2 * D_FF), D_MODEL ** -0.5),
        'w_ffn_down': nrm(ks[19], (DEPTH, D_FF, D_MODEL), D_FF ** -0.5),
        'normf_g': 1.0 + nrm(ks[20], (D_MODEL,), 0.02),
    }


def reference(x_prompt, x_sample, cache_k, cache_v, state_ret, meta_tokens, rel_bias, norm1_g, w_in,
              lambda_q1, lambda_k1, lambda_q2, lambda_k2, diff_subln_g, w_ret_branch, w_diff_branch,
              w_o, norm2_g, w_ffn_up, w_ffn_down, normf_g):
    B = x_prompt.shape[0]
    pad = jnp.zeros((B, PREFIX - N_META, D_MODEL), x_prompt.dtype)
    meta = jnp.broadcast_to(meta_tokens.astype(x_prompt.dtype)[None], (B, N_META, D_MODEL))
    h_p = jnp.concatenate([pad, meta, x_prompt], axis=1)
    h_s = x_sample
    kp, vp, sp, ksm, vsm, ssm = [], [], [], [], [], []
    for l in range(DEPTH):
        lw = (norm1_g[l], w_in[l], lambda_q1[l], lambda_k1[l], lambda_q2[l], lambda_k2[l], diff_subln_g[l],
              w_ret_branch[l], w_diff_branch[l], w_o[l], norm2_g[l], w_ffn_up[l], w_ffn_down[l])
        lam_init = 0.8 - 0.6 * math.exp(-0.3 * l)
        h_p, k_new, v_new, s_new = prompt_layer(h_p, lw, lam_init, rel_bias)
        kp.append(k_new)
        vp.append(v_new)
        sp.append(s_new)
        h_s, k_new, v_new, s_new = sample_layer(h_s, cache_k[l], cache_v[l], state_ret[l], lw, lam_init, rel_bias)
        ksm.append(k_new)
        vsm.append(v_new)
        ssm.append(s_new)
    y_prompt = rmsnorm(h_p[:, PREFIX:], normf_g)
    y_sample = rmsnorm(h_s, normf_g)
    return (y_prompt, y_sample, jnp.stack(kp), jnp.stack(vp), jnp.stack(sp), jnp.stack(ksm), jnp.stack(vsm), jnp.stack(ssm))
```

```cpp
#include <hip/hip_runtime.h>
#include <hip/hip_cooperative_groups.h>
#include <cstdio>
#include <cstdint>
namespace cg = cooperative_groups;
namespace pg8 {
#define PG8_LAS __attribute__((address_space(3)))
typedef unsigned short bf16_t;
typedef short bf16x8 __attribute__((ext_vector_type(8)));
typedef float f32x4 __attribute__((ext_vector_type(4)));
typedef unsigned u32x4 __attribute__((ext_vector_type(4)));
constexpr int BM = 256, BK = 64, HALF = 128, HTB = HALF * BK * 2  , STAGE_BYTES = 8 * HTB, NXCD = 8, WGM = 8;

__host__ __device__ __forceinline__ int lds_byte(int r, int c) { const int st = (r >> 4) * 2 + (c >> 5), rr = r & 15, cc = c & 31, ob = rr * 64 + cc * 2; return st * 1024 + (ob ^ (((ob >> 9) & 1) << 5)); }
__host__ __device__ __forceinline__ void stage_rc(int b, int& R, int& C) { const int st = b / 1024, sb = b % 1024, swz = sb ^ (((sb >> 9) & 1) << 5); R = (st >> 1) * 16 + swz / 64; C = (st & 1) * 32 + (swz % 64) / 2; }
__host__ __device__ __forceinline__ int perm32(int rho) { const int n = rho >> 4, i = rho & 15; return 8 * (i >> 2) + 4 * n + (i & 3); }

struct Unit { int pm, pn; };
struct Gemm { const bf16_t* A; const bf16_t* Bt; int M, N, K; };

struct StaticOrder {
    int nM, nN, nwg, G, c;
    __host__ __device__ void init(int M, int N, int G_, int c_) { nM = M / BM; nN = N / BM; nwg = nM * nN; G = G_; c = c_; }
    __host__ __device__ bool next(int i, Unit& u) const {
        const long L = (long)i * G + c; if (L >= nwg) return false;
        int wgid = (int)L; { const int q = nwg / NXCD, r = nwg % NXCD, xcd = wgid % NXCD, off = wgid / NXCD; wgid = (xcd < r ? xcd * (q + 1) : r * (q + 1) + (xcd - r) * q) + off; }
        const int nig = WGM * nN, gid = wgid / nig, fm = gid * WGM, gsz = (nM - fm) < WGM ? (nM - fm) : WGM;
        u.pm = fm + ((wgid % nig) % gsz); u.pn = (wgid % nig) / gsz; return true;
    }
    __device__ __forceinline__ void a_ready(const Unit&) const {}
    __device__ __forceinline__ void done(const Unit&) const {}
};

__device__ __forceinline__ unsigned cvt_pk_bf16(float lo, float hi) { unsigned r; asm volatile("v_cvt_pk_bf16_f32 %0, %1, %2" : "=v"(r) : "v"(lo), "v"(hi)); return r; }
template <class Epi, class Sched, bool ALIGN_EPI = false, bool SP2 = false>
__device__ __forceinline__ void gemm_phase(PG8_LAS unsigned char* lds, const Gemm g, const Sched& S, const Epi& E, int wave_s) {
    asm volatile("" : "+s"(wave_s));
    unsigned mall = ~0u; asm volatile("" : "+s"(mall));
    int tid = wave_s * 64 + (int)__builtin_amdgcn_mbcnt_hi(mall, __builtin_amdgcn_mbcnt_lo(mall, 0u)); asm volatile("" : "+v"(tid));
    const int wid = __builtin_amdgcn_readfirstlane(tid >> 6), lane = tid & 63, wr = wid >> 2, wc = wid & 3, fr = lane & 15, fq = lane >> 4;
    const int K = g.K, nt = K / BK;
    unsigned voffA[2], voffB[2];
#pragma unroll
    for (int i = 0; i < 2; ++i) { int R, C; stage_rc(tid * 16 + i * 8192, R, C); const int Rb = Epi::PERM ? ((R & ~31) + perm32(R & 31)) : R;
        voffA[i] = (unsigned)(R * K + C) * 2u; voffB[i] = (unsigned)(Rb * K + C) * 2u; }
    const size_t kstep = (size_t)(BK * 2);
    const size_t hstep = (size_t)HALF * K * 2;
    const size_t tstep = 2 * hstep;
    const unsigned ldsw = (unsigned)wid * 1024u;
    const int aoff = lds_byte(wr * 64 + fr, fq * 8), boff = lds_byte(wc * 32 + fr, fq * 8);
#define PG8_SA(b, h) (((b) * 2 + (h)) * HTB)
#define PG8_SB(b, h) ((4 + (b) * 2 + (h)) * HTB)
#define PG8_STAGE(bufoff, gbase, voff) do { _Pragma("unroll") for (int _i = 0; _i < 2; ++_i) \
        __builtin_amdgcn_global_load_lds((const unsigned*)((const char*)(gbase) + (voff)[_i]), (PG8_LAS unsigned*)(lds + (bufoff) + ldsw + _i * 8192), 16, 0, 0); } while (0)
#define PG8_LDA(dst, b, h) do { _Pragma("unroll") for (int m = 0; m < 4; ++m) _Pragma("unroll") for (int k = 0; k < 2; ++k) dst[m][k] = *(const PG8_LAS bf16x8*)(lds + PG8_SA(b, h) + aoff + m * 2048 + k * 1024); } while (0)
#define PG8_LDB(dst, b, h) do { _Pragma("unroll") for (int n = 0; n < 2; ++n) _Pragma("unroll") for (int k = 0; k < 2; ++k) dst[n][k] = *(const PG8_LAS bf16x8*)(lds + PG8_SB(b, h) + boff + n * 2048 + k * 1024); } while (0)
#define PG8_MMA(ai, bj, At, Bt) do { __builtin_amdgcn_s_setprio(1); _Pragma("unroll") for (int m = 0; m < 4; ++m) _Pragma("unroll") for (int n = 0; n < 2; ++n) _Pragma("unroll") for (int k = 0; k < 2; ++k) \
        acc[ai][bj][m][n] = __builtin_amdgcn_mfma_f32_16x16x32_bf16(Bt[n][k], At[m][k], acc[ai][bj][m][n], 0, 0, 0); __builtin_amdgcn_s_setprio(0); } while (0)
#define PG8_WAIT_V(n) asm volatile("s_waitcnt vmcnt(" #n ")" ::: "memory")
#define PG8_WAIT_L(n) asm volatile("s_waitcnt lgkmcnt(" #n ")" ::: "memory")
#define PG8_BAR __builtin_amdgcn_s_barrier()
#define PG8_SCHED __builtin_amdgcn_sched_barrier(0)
    Unit cur, nxt; int ui = 0;
    if (!S.next(0, cur)) return;
    f32x4 acc[2][2][4][2];
#pragma unroll
    for (int a = 0; a < 2; ++a)
#pragma unroll
        for (int b = 0; b < 2; ++b)
#pragma unroll
            for (int m = 0; m < 4; ++m)
#pragma unroll
                for (int n = 0; n < 2; ++n) acc[a][b][m][n] = (f32x4){0.f, 0.f, 0.f, 0.f};
    bf16x8 At[4][2], B0[2][2], B1[2][2];
    const char* cA = (const char*)g.A + (size_t)cur.pm * tstep; const char* cB = (const char*)g.Bt + (size_t)cur.pn * tstep;
    S.a_ready(cur);
    if constexpr (SP2) {
        PG8_STAGE(PG8_SB(0, 0), cB, voffB); PG8_STAGE(PG8_SB(0, 1), cB + hstep, voffB); PG8_STAGE(PG8_SA(0, 0), cA, voffA); PG8_STAGE(PG8_SA(0, 1), cA + hstep, voffA);
        if (wr == 1) PG8_BAR;
        PG8_WAIT_V(2); PG8_BAR;
        PG8_STAGE(PG8_SB(1, 0), cB + kstep, voffB); PG8_STAGE(PG8_SA(1, 0), cA + kstep, voffA); PG8_STAGE(PG8_SB(1, 1), cB + hstep + kstep, voffB);
        PG8_WAIT_V(6); PG8_BAR;
    } else {
        PG8_STAGE(PG8_SB(0, 0), cB, voffB); PG8_STAGE(PG8_SA(0, 0), cA, voffA); PG8_STAGE(PG8_SB(0, 1), cB + hstep, voffB); PG8_STAGE(PG8_SA(0, 1), cA + hstep, voffA);
        if (wr == 1) PG8_BAR;
        PG8_WAIT_V(4); PG8_BAR;
        PG8_STAGE(PG8_SB(1, 0), cB + kstep, voffB); PG8_STAGE(PG8_SA(1, 0), cA + kstep, voffA); PG8_STAGE(PG8_SB(1, 1), cB + hstep + kstep, voffB);
        PG8_WAIT_V(6); PG8_BAR;
    }
    for (;;) {
        const bool has_next = S.next(ui + 1, nxt);
        const char* nA = has_next ? (const char*)g.A + (size_t)nxt.pm * tstep : cA; const char* nB = has_next ? (const char*)g.Bt + (size_t)nxt.pn * tstep : cB;
        for (int t = 0; t < nt; t += 2) {
            const bool last = (t == nt - 2);
            const char* a1 = cA + (size_t)(t + 1) * kstep;
            const char* a2 = last ? nA : cA + (size_t)(t + 2) * kstep; const char* b2 = last ? nB : cB + (size_t)(t + 2) * kstep;
            const char* a3 = a2 + kstep; const char* b3 = b2 + kstep;
            if (last && has_next) S.a_ready(nxt);
            if constexpr (SP2) {
            PG8_LDB(B0, 0, 0); PG8_LDB(B1, 0, 1); PG8_SCHED; PG8_LDA(At, 0, 0); PG8_STAGE(PG8_SA(1, 1), a1 + hstep, voffA);
            PG8_WAIT_V(8); PG8_WAIT_L(0); PG8_BAR; PG8_MMA(0, 0, At, B0); PG8_MMA(0, 1, At, B1); PG8_BAR; PG8_SCHED;
            PG8_LDA(At, 0, 1); PG8_STAGE(PG8_SB(0, 0), b2, voffB); PG8_STAGE(PG8_SB(0, 1), b2 + hstep, voffB); PG8_STAGE(PG8_SA(0, 0), a2, voffA);
            PG8_WAIT_V(8); PG8_WAIT_L(0); PG8_BAR; PG8_MMA(1, 0, At, B0); PG8_MMA(1, 1, At, B1); PG8_BAR; PG8_SCHED;
            PG8_LDB(B0, 1, 0); PG8_LDB(B1, 1, 1); PG8_SCHED; PG8_LDA(At, 1, 0); PG8_STAGE(PG8_SA(0, 1), a2 + hstep, voffA);
            PG8_WAIT_V(8); PG8_WAIT_L(0); PG8_BAR; PG8_MMA(0, 0, At, B0); PG8_MMA(0, 1, At, B1); PG8_BAR; PG8_SCHED;
            PG8_LDA(At, 1, 1); PG8_STAGE(PG8_SB(1, 0), b3, voffB); PG8_STAGE(PG8_SB(1, 1), b3 + hstep, voffB); PG8_STAGE(PG8_SA(1, 0), a3, voffA);
            PG8_WAIT_V(8); PG8_WAIT_L(0); PG8_BAR; PG8_MMA(1, 0, At, B0); PG8_MMA(1, 1, At, B1); PG8_BAR; PG8_SCHED;
            } else {
            PG8_LDB(B0, 0, 0); PG8_SCHED; PG8_LDA(At, 0, 0); PG8_STAGE(PG8_SA(1, 1), a1 + hstep, voffA);
            PG8_WAIT_L(8); PG8_BAR; PG8_WAIT_L(0); PG8_MMA(0, 0, At, B0); PG8_BAR; PG8_SCHED;
            PG8_LDB(B1, 0, 1); PG8_STAGE(PG8_SB(0, 0), b2, voffB);
            PG8_BAR; PG8_WAIT_L(0); PG8_MMA(0, 1, At, B1); PG8_BAR;
            PG8_LDA(At, 0, 1); PG8_STAGE(PG8_SA(0, 0), a2, voffA);
            PG8_BAR; PG8_WAIT_L(0); PG8_MMA(1, 0, At, B0); PG8_BAR; PG8_SCHED;
            PG8_STAGE(PG8_SB(0, 1), b2 + hstep, voffB);
            PG8_WAIT_V(6); PG8_BAR; PG8_MMA(1, 1, At, B1); PG8_BAR;
            PG8_LDB(B0, 1, 0); PG8_SCHED; PG8_LDA(At, 1, 0); PG8_STAGE(PG8_SA(0, 1), a2 + hstep, voffA);
            PG8_WAIT_L(8); PG8_BAR; PG8_WAIT_L(0); PG8_MMA(0, 0, At, B0); PG8_BAR; PG8_SCHED;
            PG8_LDB(B1, 1, 1); PG8_STAGE(PG8_SB(1, 0), b3, voffB);
            PG8_BAR; PG8_WAIT_L(0); PG8_MMA(0, 1, At, B1); PG8_BAR;
            PG8_LDA(At, 1, 1); PG8_STAGE(PG8_SA(1, 0), a3, voffA);
            PG8_BAR; PG8_WAIT_L(0); PG8_MMA(1, 0, At, B0); PG8_BAR; PG8_SCHED;
            PG8_STAGE(PG8_SB(1, 1), b3 + hstep, voffB);
            PG8_WAIT_V(6); PG8_BAR; PG8_MMA(1, 1, At, B1); PG8_BAR;
            }
        }
        if constexpr (ALIGN_EPI) { if (wr == 0) PG8_BAR; }
        if constexpr (!Epi::AFTER_DRAIN) { E(acc, cur, wr, wc, fr, fq); S.done(cur); }
        if (!has_next) break;
#pragma unroll
        for (int a = 0; a < 2; ++a)
#pragma unroll
            for (int b = 0; b < 2; ++b)
#pragma unroll
                for (int m = 0; m < 4; ++m)
#pragma unroll
                    for (int n = 0; n < 2; ++n) acc[a][b][m][n] = (f32x4){0.f, 0.f, 0.f, 0.f};
        cur = nxt; cA = nA; cB = nB; ++ui;
        if constexpr (ALIGN_EPI) { if (wr == 1) PG8_BAR; }
    }
    PG8_WAIT_V(0);
    if constexpr (!ALIGN_EPI) { if (wr == 0) PG8_BAR; }
    PG8_BAR;
    if constexpr (Epi::AFTER_DRAIN) { E.fused(acc, cur, wr, wc, fr, fq, lds, wid, lane); S.done(cur); }
#undef PG8_SA
#undef PG8_SB
#undef PG8_STAGE
#undef PG8_LDA
#undef PG8_LDB
#undef PG8_MMA
#undef PG8_WAIT_V
#undef PG8_WAIT_L
#undef PG8_BAR
#undef PG8_SCHED
}
}

#define LAS __attribute__((address_space(3)))
typedef unsigned short bf16;
typedef unsigned u32x4 __attribute__((ext_vector_type(4)));
typedef unsigned u32x2 __attribute__((ext_vector_type(2)));
typedef float f32x4 __attribute__((ext_vector_type(4)));
typedef float f32x16 __attribute__((ext_vector_type(16)));
typedef short bf16x8 __attribute__((ext_vector_type(8)));
typedef short v4s __attribute__((ext_vector_type(4)));
using pg8::cvt_pk_bf16;

constexpr int D = 1024, SEQ = 8192, NB = 4, NSB = 16, SL = 16, PAST = 1024, DFF = 2816;
constexpr int R_ALL = 33280, R_TAIL = 33024, ROW_S0 = 32768, ROW_M0 = 33024;
constexpr int KROWS = 8208;
constexpr float LOG2E = 1.4426950408889634f;
constexpr float QSCALE = 0.125f * 1.4426950408889634f;
constexpr size_t O_YP = 0, O_YS = 33554432, O_KP = 33816576, O_VP = 67436544, O_SP = 101056512, O_KS = 101580800, O_VS = 101842944, O_SS = 102105088;
constexpr size_t MiB = 1u << 20;
constexpr size_t WS_CTL = 0, CTL_BYTES = 65536;
constexpr size_t WS_WIN = 1 * MiB, WS_WRB = 17 * MiB, WS_WDB = 19 * MiB, WS_WO = 21 * MiB, WS_WUP = 23 * MiB, WS_WDN = 34 * MiB;
constexpr size_t WS_CS = 40 * MiB, WS_SS1 = 45 * MiB, WS_SS2 = 48 * MiB;
constexpr size_t WS_XN = 52 * MiB, WS_QR = 117 * MiB, WS_KR = WS_QR + (size_t)R_ALL * 512 * 2, WS_VR = 182 * MiB, WS_DQ = 247 * MiB;
constexpr size_t WS_DK = 312 * MiB, WS_DV = 377 * MiB, WS_RG = 442 * MiB, WS_END = 507 * MiB;
constexpr size_t WS_H1B = WS_XN, WS_MG = WS_DV, WS_HID = WS_QR, WS_YD = WS_DQ, WS_LS = WS_XN, WS_H2B = WS_MG;
constexpr int CW_QUEUE = 8192, CW_XQ = 8448;
constexpr int LDS_BYTES = 147456;
constexpr int LDS_MISC = 143360;

struct Ctx {
    const float *x_prompt, *x_sample, *cache_k, *cache_v, *state_ret, *meta, *rel_bias, *n1g, *w_in, *lq1, *lk1, *lq2, *lk2, *subg,
                *w_rb, *w_db, *w_o, *n2g, *w_up, *w_down, *nfg;
    float* out; unsigned char* ws;
};

__device__ __forceinline__ float wave_sum(float v) {
#pragma unroll
    for (int o = 1; o < 64; o <<= 1) v += __shfl_xor(v, o);
    return v;
}
__device__ __forceinline__ unsigned f2bf(float f) { unsigned u = __builtin_bit_cast(unsigned, f); return (u + 0x7fffu + ((u >> 16) & 1u)) >> 16; }
__device__ __forceinline__ float bf2f(unsigned short b) { return __builtin_bit_cast(float, (unsigned)b << 16); }
__device__ __forceinline__ float sigm_f(float x) { return __builtin_amdgcn_rcpf(1.f + __builtin_amdgcn_exp2f(-1.4426950408889634f * x)); }
__device__ __forceinline__ float silu_f(float x) { return x * sigm_f(x); }
__device__ __forceinline__ int fresh_tid(int wave_s) { unsigned m = ~0u; asm volatile("" : "+s"(m)); int t = wave_s * 64 + (int)__builtin_amdgcn_mbcnt_hi(m, __builtin_amdgcn_mbcnt_lo(m, 0u)); asm volatile("" : "+v"(t)); return t; }
__device__ __forceinline__ u32x4 pack8(const f32x4& a, const f32x4& b) {
    u32x4 w; w.x = cvt_pk_bf16(a[0], a[1]); w.y = cvt_pk_bf16(a[2], a[3]); w.z = cvt_pk_bf16(b[0], b[1]); w.w = cvt_pk_bf16(b[2], b[3]); return w;
}
__device__ __forceinline__ void unpack8(const u32x4& w, float* f) {
    f[0] = __builtin_bit_cast(float, w.x << 16); f[1] = __builtin_bit_cast(float, w.x & 0xffff0000u);
    f[2] = __builtin_bit_cast(float, w.y << 16); f[3] = __builtin_bit_cast(float, w.y & 0xffff0000u);
    f[4] = __builtin_bit_cast(float, w.z << 16); f[5] = __builtin_bit_cast(float, w.z & 0xffff0000u);
    f[6] = __builtin_bit_cast(float, w.w << 16); f[7] = __builtin_bit_cast(float, w.w & 0xffff0000u);
}
__device__ __forceinline__ int crow(int r, int hi) { return (r & 3) + 8 * (r >> 2) + 4 * hi; }
__device__ __forceinline__ v4s tr16(LAS const unsigned char* p) { return __builtin_amdgcn_ds_read_tr16_b64_v4i16((LAS v4s*)p); }
#define MFMA32(a, b, c) __builtin_amdgcn_mfma_f32_32x32x16_bf16((a), (b), (c), 0, 0, 0)
__device__ __forceinline__ bf16x8 cat4(v4s lo, v4s hi) { return __builtin_shufflevector(lo, hi, 0, 1, 2, 3, 4, 5, 6, 7); }
__device__ __forceinline__ bf16x8 pack_step(const f32x16& x, int s) {
    u32x4 p; p.x = cvt_pk_bf16(x[8 * s], x[8 * s + 1]); p.y = cvt_pk_bf16(x[8 * s + 2], x[8 * s + 3]); p.z = cvt_pk_bf16(x[8 * s + 4], x[8 * s + 5]); p.w = cvt_pk_bf16(x[8 * s + 6], x[8 * s + 7]);
    return __builtin_bit_cast(bf16x8, p);
}

#define XB_TMO      128
#define XB_XCNT(j)  (256  + 64 * (j))
#define XB_XSUB(j)  (1280 + 64 * (j))
#define XB_XGEN(j)  (2304 + 64 * (j))
#define XB_TOP      3328
#define XB_TOPGEN   3392
#define XCD_BAR_WORDS 3456
#define XB_SPIN_CAP (1u << 22)
__device__ __forceinline__ unsigned xb_ld(unsigned* p)              { return __hip_atomic_load(p, __ATOMIC_RELAXED, __HIP_MEMORY_SCOPE_AGENT); }
__device__ __forceinline__ unsigned xb_add(unsigned* p, unsigned v) { return __hip_atomic_fetch_add(p, v, __ATOMIC_RELAXED, __HIP_MEMORY_SCOPE_AGENT); }
__device__ __forceinline__ unsigned xb_xcc_id() { return (unsigned)__builtin_amdgcn_s_getreg((3 << 11) | 20) & 0xFu; }
#define XB_SPIN(cond, bar) do { unsigned _sp = 0; while (cond) { __builtin_amdgcn_s_sleep(1); \
    if ((++_sp & 255u) == 0u) { if (xb_ld(&(bar)[XB_TMO])) break; if (_sp > XB_SPIN_CAP) { atomicAdd(&(bar)[XB_TMO], 1u); break; } } } } while (0)
struct XcdBarrier { unsigned* bar; unsigned x; volatile LAS unsigned* st; int wave_s; };
__device__ __forceinline__ XcdBarrier xcd_barrier_post(unsigned* bar, volatile LAS unsigned* st, int wave_s) {
    XcdBarrier b; b.bar = bar; b.x = xb_xcc_id(); b.st = st; b.wave_s = wave_s;
    if (fresh_tid(wave_s) == 0) (void)xb_add(&bar[XB_XCNT(b.x)], 1u);
    return b;
}
__device__ __forceinline__ void xcd_barrier_complete(unsigned* bar, unsigned x, unsigned& nloc, unsigned& nx) {
    const unsigned G = gridDim.x * gridDim.y * gridDim.z;
    unsigned sum, cnt, mine, sp = 0u;
    for (;;) {
        sum = 0u; cnt = 0u; mine = 0u;
#pragma unroll
        for (unsigned j = 0; j < 16; ++j) { const unsigned c = xb_ld(&bar[XB_XCNT(j)]); sum += c; cnt += (c > 0u) ? 1u : 0u; mine = (j == x) ? c : mine; }
        if (sum == G) break;
        __builtin_amdgcn_s_sleep(1);
        if ((++sp & 255u) == 0u) { if (xb_ld(&bar[XB_TMO])) break; if (sp > XB_SPIN_CAP) { atomicAdd(&bar[XB_TMO], 1u); break; } }
    }
    nloc = mine > 0u ? mine : 1u; nx = cnt > 0u ? cnt : 1u;
}
__device__ __forceinline__ void xcd_barrier(const XcdBarrier& b) {
    asm volatile("s_waitcnt vmcnt(0)" ::: "memory");
    __syncthreads();
    if (fresh_tid(b.wave_s) == 0) {
        unsigned* bar = b.bar;
        __builtin_amdgcn_s_waitcnt(0);
        unsigned nloc = b.st[0], nx = b.st[1];
        if (nloc == 0u) { xcd_barrier_complete(bar, b.x, nloc, nx); b.st[0] = nloc; b.st[1] = nx; }
        const unsigned old = xb_add(&bar[XB_XSUB(b.x)], 1u);
        const unsigned gen = old / nloc;
        if (old + 1u == (gen + 1u) * nloc) {
            __builtin_amdgcn_fence(__ATOMIC_RELEASE, "agent");
            asm volatile("s_waitcnt vmcnt(0)" ::: "memory");
            const unsigned og = xb_add(&bar[XB_TOP], 1u);
            const unsigned tg = og / nx;
            if (og + 1u == (tg + 1u) * nx) xb_add(&bar[XB_TOPGEN], 1u);
            else XB_SPIN(xb_ld(&bar[XB_TOPGEN]) == tg, bar);
            __builtin_amdgcn_fence(__ATOMIC_ACQUIRE, "agent");
            xb_add(&bar[XB_XGEN(b.x)], 1u);
            asm volatile("s_waitcnt vmcnt(0)" ::: "memory");
        } else {
            XB_SPIN(xb_ld(&bar[XB_XGEN(b.x)]) == gen, bar);
            __builtin_amdgcn_fence(__ATOMIC_ACQUIRE, "agent");
            asm volatile("s_waitcnt vmcnt(0)" ::: "memory");
        }
    }
    __syncthreads();
}

__device__ __forceinline__ int win_src(int n) {
    if (n >= 1024) return n;
    const int hh = n >> 7, p = n & 127, dd = 4 * (p >> 3) + (p & 3), half = (p >> 2) & 1;
    return hh * 128 + 64 * half + dd;
}
__device__ __forceinline__ int wup_src(int n) { const int pn = n >> 8, lc = n & 255; return (lc >> 7) * DFF + 128 * pn + (lc & 127); }
template <int MODE> __device__ __forceinline__ void transpose_item(const float* W, int K, int N, bf16* WT, LAS float* scr, int item, int lane, const float* kscale) {
    const int nblk = N / 32, kb = item / nblk, nb = item % nblk, k0 = 64 * kb, n0 = 32 * nb;
    const int l8 = lane & 7, kr = lane >> 3;
    const int nn = n0 + 4 * l8; const int src = MODE == 1 ? win_src(nn) : (MODE == 2 ? wup_src(nn) : nn);
#pragma unroll
    for (int i = 0; i < 8; ++i) { const int kk = 8 * i + kr; f32x4 v = __builtin_nontemporal_load((const f32x4*)(W + (size_t)(k0 + kk) * N + src)); if (MODE == 2) v = v * kscale[k0 + kk];
        LAS float* d = scr + kk * 33 + 4 * l8; d[0] = v[0]; d[1] = v[1]; d[2] = v[2]; d[3] = v[3]; }
    asm volatile("s_waitcnt lgkmcnt(0)" ::: "memory");
    const int c = lane & 7;
#pragma unroll
    for (int j = 0; j < 4; ++j) { const int n = (lane >> 3) + 8 * j; const LAS float* s = scr + (8 * c) * 33 + n;
        u32x4 o; o.x = cvt_pk_bf16(s[0 * 33], s[1 * 33]); o.y = cvt_pk_bf16(s[2 * 33], s[3 * 33]); o.z = cvt_pk_bf16(s[4 * 33], s[5 * 33]); o.w = cvt_pk_bf16(s[6 * 33], s[7 * 33]);
        *(u32x4*)(WT + (size_t)(n0 + n) * K + k0 + 8 * c) = o; }
    asm volatile("s_waitcnt lgkmcnt(0)" ::: "memory");
}
__device__ __forceinline__ void p0_prep(const Ctx& c, LAS unsigned char* lds, int vcu, int G, int wave_s) {
    const int tid_ = fresh_tid(wave_s); const int lane = tid_ & 63, wave = __builtin_amdgcn_readfirstlane(tid_ >> 6);
    unsigned char* ws = c.ws;
    LAS float* scr = (LAS float*)(lds + wave * 16384);
    const int gw = vcu * 8 + wave, NGW = G * 8;
    constexpr int I_IN = (D / 64) * (8192 / 32), I_SQ = (D / 64) * (D / 32), I_UP = (D / 64) * (2 * DFF / 32), I_DN = (DFF / 64) * (D / 32);
    constexpr int NITEMS = I_IN + 3 * I_SQ + I_UP + I_DN;
    for (int it = gw; it < NITEMS; it += NGW) {
        int r = it;
        if (r < I_IN) { transpose_item<1>(c.w_in, D, 8192, (bf16*)(ws + WS_WIN), scr, r, lane, nullptr); continue; } r -= I_IN;
        if (r < I_SQ) { transpose_item<0>(c.w_rb, D, D, (bf16*)(ws + WS_WRB), scr, r, lane, nullptr); continue; } r -= I_SQ;
        if (r < I_SQ) { transpose_item<0>(c.w_db, D, D, (bf16*)(ws + WS_WDB), scr, r, lane, nullptr); continue; } r -= I_SQ;
        if (r < I_SQ) { transpose_item<0>(c.w_o, D, D, (bf16*)(ws + WS_WO), scr, r, lane, nullptr); continue; } r -= I_SQ;
        if (r < I_UP) { transpose_item<2>(c.w_up, D, 2 * DFF, (bf16*)(ws + WS_WUP), scr, r, lane, c.n2g); continue; } r -= I_UP;
        transpose_item<0>(c.w_down, DFF, D, (bf16*)(ws + WS_WDN), scr, r, lane, nullptr);
    }
    bf16* XN = (bf16*)(ws + WS_XN);
    for (int m = gw; m < R_ALL; m += NGW) {
        unsigned long long* o8 = (unsigned long long*)(XN + (size_t)m * D) + lane;
        if (m >= ROW_M0 + 16) {
#pragma unroll
            for (int j = 0; j < 4; ++j) o8[64 * j] = 0ull;
            continue; }
        const float* src = m < ROW_S0 ? c.x_prompt + (size_t)m * D : (m < ROW_M0 ? c.x_sample + (size_t)(m - ROW_S0) * D : c.meta + (size_t)(m - ROW_M0) * D);
        const f32x4* xr = (const f32x4*)src + lane; const f32x4* gr = (const f32x4*)c.n1g + lane;
        f32x4 v[4]; float s = 0.f;
#pragma unroll
        for (int j = 0; j < 4; ++j) { v[j] = __builtin_nontemporal_load(xr + 64 * j); s += (v[j].x * v[j].x + v[j].y * v[j].y) + (v[j].z * v[j].z + v[j].w * v[j].w); }
        const float rstd = 1.f / sqrtf(wave_sum(s) * (1.f / D) + 1e-6f);
#pragma unroll
        for (int j = 0; j < 4; ++j) { const f32x4 g = gr[64 * j]; const f32x4 y = v[j] * rstd * g;
            o8[64 * j] = (unsigned long long)cvt_pk_bf16(y.x, y.y) | ((unsigned long long)cvt_pk_bf16(y.z, y.w) << 32); }
    }
    float2* CS = (float2*)(ws + WS_CS);
    const int gt = vcu * 512 + tid_, NGT = G * 512;
    for (int e = gt; e < KROWS * 64; e += NGT) {
        const int d = e & 63, pos = (e >> 6) - 16;
        const double fr = exp2(-(double)d * (13.287712379549449 / 63.0));
        const double rev = (double)pos * fr * 0.15915494309189535;
        const float fx = (float)(rev - rint(rev));
        CS[e] = make_float2(__builtin_amdgcn_cosf(fx), __builtin_amdgcn_sinf(fx));
    }
}

using pg8::Unit;
__device__ __forceinline__ int pos_index(int row) { return row < ROW_S0 ? (row & 8191) + 16 : (row < ROW_M0 ? 1040 + (row & 15) : (row < ROW_M0 + 16 ? row - ROW_M0 : 0)); }

struct EpiIn {
    static constexpr bool PERM = true, AFTER_DRAIN = false;
    Ctx c;
    __device__ __forceinline__ void operator()(const pg8::f32x4 (&acc)[2][2][4][2], const Unit& u, int wr, int wc, int fr, int fq) const {
        const int pn = u.pn, rbase = u.pm * 256 + wr * 64 + fr, cl = wc * 32 + 8 * fq;
        unsigned char* ws = c.ws;
        if (pn < 4) {
            const bool isq = pn < 2; bf16* dst = (bf16*)(ws + (isq ? WS_QR : WS_KR));
            const float sc = isq ? 0.08838834764831845f : 1.f; const int dd = 16 * wc + 4 * fq;
            const float2* CS = (const float2*)(ws + WS_CS);
#pragma unroll
            for (int ai = 0; ai < 2; ++ai)
#pragma unroll
                for (int m = 0; m < 4; ++m) { const int row = rbase + ai * 128 + m * 16; const f32x4* cs = (const f32x4*)(CS + (size_t)pos_index(row) * 64 + dd);
                    const f32x4 cs0 = cs[0], cs1 = cs[1];
                    const float cc[4] = {cs0[0], cs0[2], cs1[0], cs1[2]}, ss[4] = {cs0[1], cs0[3], cs1[1], cs1[3]};
#pragma unroll
                    for (int bj = 0; bj < 2; ++bj) { const f32x4 x1 = acc[ai][bj][m][0], x2 = acc[ai][bj][m][1]; float o1[4], o2[4];
#pragma unroll
                        for (int j = 0; j < 4; ++j) { o1[j] = (x1[j] * cc[j] - x2[j] * ss[j]) * sc; o2[j] = (x1[j] * ss[j] + x2[j] * cc[j]) * sc; }
                        bf16* p = dst + (size_t)row * 512 + ((pn & 1) * 2 + bj) * 128 + dd;
                        u32x2 w1, w2; w1.x = cvt_pk_bf16(o1[0], o1[1]); w1.y = cvt_pk_bf16(o1[2], o1[3]); w2.x = cvt_pk_bf16(o2[0], o2[1]); w2.y = cvt_pk_bf16(o2[2], o2[3]);
                        if (isq) { __builtin_nontemporal_store(w1, (u32x2*)p); __builtin_nontemporal_store(w2, (u32x2*)(p + 64)); } else { *(u32x2*)p = w1; *(u32x2*)(p + 64) = w2; } } }
            return;
        }
        const int grp = pn >> 2, ct = (pn & 3) * 256;
#pragma unroll
        for (int ai = 0; ai < 2; ++ai)
#pragma unroll
            for (int m = 0; m < 4; ++m) { const int row = rbase + ai * 128 + m * 16;
#pragma unroll
                for (int bj = 0; bj < 2; ++bj) { const int col = ct + bj * 128 + cl; f32x4 v0 = acc[ai][bj][m][0], v1 = acc[ai][bj][m][1];
                    if (grp == 1) { *(u32x4*)((bf16*)(ws + WS_VR) + (size_t)row * D + col) = pack8(v0, v1); }
                    else if (grp == 2) { __builtin_nontemporal_store(pack8(v0, v1), (u32x4*)((bf16*)(ws + WS_RG) + (size_t)row * D + col)); }
                    else if (grp == 3) { v0 = v0 * QSCALE; v1 = v1 * QSCALE; __builtin_nontemporal_store(pack8(v0, v1), (u32x4*)((bf16*)(ws + WS_DQ) + (size_t)row * D + col)); }
                    else if (grp == 4 || grp == 5) {
                        bf16* bb = (bf16*)(ws + (grp == 4 ? WS_DK : WS_DV)); float* fp = c.out + (grp == 4 ? O_KP : O_VP); float* fs = c.out + (grp == 4 ? O_KS : O_VS);
                        const u32x4 w = pack8(v0, v1);
                        const int hh = col >> 7, hc = col & 127;
                        if (row < ROW_S0) { const size_t rr = (size_t)(row >> 13) * KROWS + 16 + (row & 8191); const size_t hb = ((size_t)((row >> 13) * 8 + hh) * KROWS + 16 + (row & 8191)) * 128 + hc;
                            *(u32x4*)(bb + hb) = w; __builtin_nontemporal_store(v0, (f32x4*)(fp + rr * D + col)); __builtin_nontemporal_store(v1, (f32x4*)(fp + rr * D + col + 4)); }
                        else if (row < ROW_M0) { const size_t rr = (size_t)(row - ROW_S0); *(f32x4*)(fs + rr * D + col) = v0; *(f32x4*)(fs + rr * D + col + 4) = v1; }
                        else if (row < ROW_M0 + 16) {
#pragma unroll
                            for (int b = 0; b < NB; ++b) { const size_t rr = (size_t)b * KROWS + (row - ROW_M0); const size_t hb = ((size_t)(b * 8 + hh) * KROWS + (row - ROW_M0)) * 128 + hc;
                                *(u32x4*)(bb + hb) = w; *(f32x4*)(fp + rr * D + col) = v0; *(f32x4*)(fp + rr * D + col + 4) = v1; } }
                    } else {
                        if (row < ROW_M0) {
#pragma unroll
                            for (int j = 0; j < 4; ++j) { v0[j] = sigm_f(v0[j]); v1[j] = sigm_f(v1[j]); }
                            bf16* g = row < ROW_S0 ? (bf16*)(c.out + O_YP) + (size_t)(grp - 6) * ROW_S0 * D + (size_t)row * D
                                                   : (bf16*)(c.out + O_YS) + (size_t)(grp - 6) * 256 * D + (size_t)(row - ROW_S0) * D;
                            __builtin_nontemporal_store(pack8(v0, v1), (u32x4*)(g + col)); } }
                } }
    }
};
__device__ __forceinline__ const bf16* gate_row(const Ctx& c, int which, int row) {
    return row < ROW_S0 ? (const bf16*)(c.out + O_YP) + (size_t)which * ROW_S0 * D + (size_t)row * D : (const bf16*)(c.out + O_YS) + (size_t)which * 256 * D + (size_t)(row - ROW_S0) * D;
}
template <int WHICH> struct EpiBranch {
    static constexpr bool PERM = true, AFTER_DRAIN = false;
    Ctx c;
    __device__ __forceinline__ void operator()(const pg8::f32x4 (&acc)[2][2][4][2], const Unit& u, int wr, int wc, int fr, int fq) const {
        const int rbase = u.pm * 256 + wr * 64 + fr, cl = u.pn * 256 + wc * 32 + 8 * fq; bf16* MG = (bf16*)(c.ws + WS_MG);
#pragma unroll
        for (int ai = 0; ai < 2; ++ai)
#pragma unroll
            for (int m = 0; m < 4; ++m) { const int row = rbase + ai * 128 + m * 16; const bf16* g = gate_row(c, WHICH, row);
#pragma unroll
                for (int bj = 0; bj < 2; ++bj) { const int col = cl + bj * 128; float gf[8]; unpack8(__builtin_nontemporal_load((const u32x4*)(g + col)), gf);
                    f32x4 v0 = acc[ai][bj][m][0], v1 = acc[ai][bj][m][1];
                    if (WHICH == 1) { float tf[8]; unpack8(*(const u32x4*)(MG + (size_t)row * D + col), tf);
#pragma unroll
                        for (int j = 0; j < 4; ++j) { v0[j] = tf[j] + gf[j] * v0[j]; v1[j] = tf[4 + j] + gf[4 + j] * v1[j]; } }
                    else {
#pragma unroll
                        for (int j = 0; j < 4; ++j) { v0[j] = gf[j] * v0[j]; v1[j] = gf[4 + j] * v1[j]; } }
                    *(u32x4*)(MG + (size_t)row * D + col) = pack8(v0, v1); } }
    }
};
__device__ __forceinline__ float* yrow(const Ctx& c, int row) { return row < ROW_S0 ? c.out + O_YP + (size_t)row * D : c.out + O_YS + (size_t)(row - ROW_S0) * D; }
template <int WHICH> struct EpiResid {
    static constexpr bool PERM = true, AFTER_DRAIN = false;
    Ctx c;
    __device__ __forceinline__ void operator()(const pg8::f32x4 (&acc)[2][2][4][2], const Unit& u, int wr, int wc, int fr, int fq) const {
        const int rbase = u.pm * 256 + wr * 64 + fr, cl = u.pn * 256 + wc * 32 + 8 * fq; bf16* HB = (bf16*)(c.ws + WS_H1B); bf16* H2 = (bf16*)(c.ws + WS_H2B);
        float* SS = (float*)(c.ws + (WHICH == 0 ? WS_SS1 : WS_SS2));
#pragma unroll
        for (int ai = 0; ai < 2; ++ai)
#pragma unroll
            for (int m = 0; m < 4; ++m) { const int row = rbase + ai * 128 + m * 16;
                const float* xin = row < ROW_S0 ? c.x_prompt + (size_t)row * D : c.x_sample + (size_t)(row - ROW_S0) * D;
                float s = 0.f;
#pragma unroll
                for (int bj = 0; bj < 2; ++bj) { const int col = cl + bj * 128; f32x4 v0, v1;
                    if (WHICH == 0) { v0 = acc[ai][bj][m][0] + __builtin_nontemporal_load((const f32x4*)(xin + col)); v1 = acc[ai][bj][m][1] + __builtin_nontemporal_load((const f32x4*)(xin + col + 4));
                        *(u32x4*)(HB + (size_t)row * D + col) = pack8(v0, v1); }
                    else { float hf[8]; unpack8(*(const u32x4*)(HB + (size_t)row * D + col), hf);
#pragma unroll
                        for (int j = 0; j < 4; ++j) { v0[j] = acc[ai][bj][m][0][j] + hf[j]; v1[j] = acc[ai][bj][m][1][j] + hf[4 + j]; }
                        *(u32x4*)(H2 + (size_t)row * D + col) = pack8(v0, v1); }
                    s += (v0[0] * v0[0] + v0[1] * v0[1]) + (v0[2] * v0[2] + v0[3] * v0[3]) + (v1[0] * v1[0] + v1[1] * v1[1]) + (v1[2] * v1[2] + v1[3] * v1[3]); }
                s += __shfl_xor(s, 16); s += __shfl_xor(s, 32);
                if (fq == 0) SS[(size_t)row * 16 + u.pn * 4 + wc] = s; }
    }
};
struct EpiUp {
    static constexpr bool PERM = true, AFTER_DRAIN = false;
    Ctx c;
    __device__ __forceinline__ void operator()(const pg8::f32x4 (&acc)[2][2][4][2], const Unit& u, int wr, int wc, int fr, int fq) const {
        const int rbase = u.pm * 256 + wr * 64 + fr, col = u.pn * 128 + wc * 32 + 8 * fq; bf16* HID = (bf16*)(c.ws + WS_HID); const float* SS = (const float*)(c.ws + WS_SS1);
#pragma unroll
        for (int ai = 0; ai < 2; ++ai)
#pragma unroll
            for (int m = 0; m < 4; ++m) { const int row = rbase + ai * 128 + m * 16; const f32x4* sp = (const f32x4*)(SS + (size_t)row * 16);
                const f32x4 a = sp[0], b = sp[1], cc = sp[2], dd = sp[3];
                const float tot = ((a[0] + a[1]) + (a[2] + a[3])) + ((b[0] + b[1]) + (b[2] + b[3])) + ((cc[0] + cc[1]) + (cc[2] + cc[3])) + ((dd[0] + dd[1]) + (dd[2] + dd[3]));
                const float rstd = 1.f / sqrtf(tot * (1.f / D) + 1e-6f);
                f32x4 h0, h1;
#pragma unroll
                for (int j = 0; j < 4; ++j) { h0[j] = silu_f(acc[ai][0][m][0][j] * rstd) * (acc[ai][1][m][0][j] * rstd); h1[j] = silu_f(acc[ai][0][m][1][j] * rstd) * (acc[ai][1][m][1][j] * rstd); }
                *(u32x4*)(HID + (size_t)row * DFF + col) = pack8(h0, h1); }
    }
};


template <int NB, class F> __device__ __forceinline__ void small_gemm(const bf16* A, int K, const bf16* const (&Bs)[NB], int rg, int wave_s, LAS unsigned char* lds, const F& epi) {
    const int tid = fresh_tid(wave_s), lane = tid & 63, w = wave_s, r32 = lane & 31, hi = lane >> 5;
    const int kw = K >> 3, steps = kw >> 4;
    const bf16* ap = A + (size_t)(ROW_S0 + 32 * rg + r32) * K + w * kw + 8 * hi;
    const bf16* bp[NB];
#pragma unroll
    for (int nb = 0; nb < NB; ++nb) bp[nb] = Bs[nb] + (size_t)r32 * K + w * kw + 8 * hi;
    f32x16 acc[NB];
#pragma unroll
    for (int nb = 0; nb < NB; ++nb)
#pragma unroll
        for (int i = 0; i < 16; ++i) acc[nb][i] = 0.f;
    for (int s0 = 0; s0 < steps; s0 += 8) {
        bf16x8 af[8], bfr[NB][8];
#pragma unroll
        for (int s = 0; s < 8; ++s) if (s0 + s < steps) { af[s] = *(const bf16x8*)(ap + 16 * (s0 + s));
#pragma unroll
            for (int nb = 0; nb < NB; ++nb) bfr[nb][s] = *(const bf16x8*)(bp[nb] + 16 * (s0 + s)); }
#pragma unroll
        for (int s = 0; s < 8; ++s) if (s0 + s < steps) {
#pragma unroll
            for (int nb = 0; nb < NB; ++nb) acc[nb] = MFMA32(af[s], bfr[nb][s], acc[nb]); }
    }
    LAS float* P = (LAS float*)lds;
#pragma unroll
    for (int nb = 0; nb < NB; ++nb)
#pragma unroll
        for (int i = 0; i < 16; ++i) P[((w * NB + nb) * 16 + i) * 64 + lane] = acc[nb][i];
    __syncthreads();
    float v[NB][2];
#pragma unroll
    for (int nb = 0; nb < NB; ++nb)
#pragma unroll
        for (int ii = 0; ii < 2; ++ii) { float t = 0.f;
#pragma unroll
            for (int ww = 0; ww < 8; ++ww) t += P[((ww * NB + nb) * 16 + 2 * w + ii) * 64 + lane];
            v[nb][ii] = t; }
    epi(v, w, r32, hi);
    __syncthreads();
}

constexpr int A_RSK = 272, A_RSV = 320, A_KSZ = 64 * A_RSK, A_VSZ = 64 * A_RSV, A_STG = A_KSZ + A_VSZ, A_Q = 2 * A_STG, A_BT = A_Q + 8 * 4096, A_END = A_BT + 1024;
__device__ __forceinline__ int t5_bucket(int rel) {
    const int n = rel < 0 ? -rel : rel; int b = rel > 0 ? 16 : 0;
    b += n < 8 ? n : (n < 12 ? 8 : (n < 16 ? 9 : (n < 23 ? 10 : (n < 32 ? 11 : (n < 46 ? 12 : (n < 64 ? 13 : (n < 91 ? 14 : 15)))))));
    return b;
}
template <bool SAMPLE, bool STORE = true> __device__ __forceinline__ void attn_unit(const Ctx& c, LAS unsigned char* lds, int b, int h, int qb, int wave_s) {
    const int tid = fresh_tid(wave_s);
    const int lane = tid & 63, wid = __builtin_amdgcn_readfirstlane(tid >> 6), r32 = lane & 31, hi = lane >> 5;
    const int g = ((wid >> 1) + 2) & 3, mp = wid & 1;
    const bool active = SAMPLE ? (g == 0) : true;
    unsigned char* ws = c.ws;
    LAS float* BT = (LAS float*)(lds + A_BT);
    if (tid < 256) { const int rel = tid - 128; BT[tid] = (c.rel_bias[t5_bucket(rel) * 8 + h] - c.rel_bias[15 * 8 + h]) * LOG2E; }
    const int tq0 = SAMPLE ? PAST : 128 * qb + 32 * g;
    const int tq = SAMPLE ? PAST + (r32 & 15) : tq0 + r32;
    const int ntiles = SAMPLE ? 17 : 2 * qb + 3;
    const int ntw = SAMPLE ? 17 : (tq0 >> 6) + 2;
    const size_t qrow = SAMPLE ? (size_t)ROW_S0 + b * 16 + (r32 & 15) : (size_t)b * SEQ + tq;
    bf16x8 qr[4];
    { const bf16* Q = (const bf16*)(ws + WS_DQ) + qrow * D + h * 128 + mp * 64 + hi * 8;
#pragma unroll
      for (int d0 = 0; d0 < 4; ++d0) qr[d0] = *(const bf16x8*)(Q + d0 * 16); }
    const int lrow = tid >> 3, lck = tid & 7;
    u32x4 kreg[2], vreg[2];
    auto load_kv = [&](int j, bool isk) {
        u32x4 r0, r1;
        if (!SAMPLE) {
            const int kidx0 = !STORE ? 64 * (j & 1) : (j == 0 ? 0 : 16 + 64 * (j - 1));
            const size_t rr = (size_t)(b * 8 + h) * KROWS + kidx0 + lrow;
            const bf16* p = (const bf16*)(ws + (isk ? WS_DK : WS_DV)) + rr * 128;
            r0 = *(const u32x4*)(p + lck * 8); r1 = *(const u32x4*)(p + 64 + lck * 8);
        } else {
            const float* p; bool ok = true;
            if (j < 16) { const size_t rr = ((size_t)b * PAST + 64 * j + lrow) * 8 + h; p = (isk ? c.cache_k : c.cache_v) + rr * 128; }
            else { ok = lrow < 16; const size_t rr = ((size_t)b * 16 + (lrow & 15)) * 8 + h; p = c.out + (isk ? O_KS : O_VS) + rr * 128; }
            r0 = pack8(*(const f32x4*)(p + lck * 8), *(const f32x4*)(p + lck * 8 + 4)); r1 = pack8(*(const f32x4*)(p + 64 + lck * 8), *(const f32x4*)(p + 64 + lck * 8 + 4));
            if (!ok) { r0 = (u32x4){0u, 0u, 0u, 0u}; r1 = r0; }
        }
        if (isk) { kreg[0] = r0; kreg[1] = r1; } else { vreg[0] = r0; vreg[1] = r1; }
    };
    auto store_k = [&](int slot) { LAS unsigned char* kb = lds + slot * A_STG + lrow * A_RSK + lck * 16; *(LAS u32x4*)kb = kreg[0]; *(LAS u32x4*)(kb + 128) = kreg[1]; };
    auto store_v = [&](int slot) { LAS unsigned char* vb = lds + slot * A_STG + A_KSZ + lrow * A_RSV + lck * 16; *(LAS u32x4*)vb = vreg[0]; *(LAS u32x4*)(vb + 128) = vreg[1]; };
    f32x16 o[4], zero16;
#pragma unroll
    for (int i = 0; i < 16; ++i) { zero16[i] = 0.f;
#pragma unroll
        for (int e = 0; e < 4; ++e) o[e][i] = 0.f; }
    float lsum = 0.f, mhat = 0.f;
    const int i16 = lane & 15, tq_ = i16 >> 2, tp_ = i16 & 3, blk = (lane >> 4) & 1;
    f32x16 p0, p1; bf16x8 pfa[4], pfb[4];
#define SB() __builtin_amdgcn_sched_barrier(0)
#define QK_TILE(ks_) do { LAS const unsigned char* kb_ = lds + (ks_) * A_STG + mp * 128 + hi * 16 + r32 * A_RSK; \
        bf16x8 kf_[8]; \
        SB(); \
        _Pragma("unroll") for (int d0 = 0; d0 < 4; ++d0) { kf_[2 * d0] = *(LAS const bf16x8*)(kb_ + d0 * 32); kf_[2 * d0 + 1] = *(LAS const bf16x8*)(kb_ + 32 * A_RSK + d0 * 32); } \
        SB(); \
        p0 = MFMA32(kf_[0], qr[0], zero16); p1 = MFMA32(kf_[1], qr[0], zero16); \
        _Pragma("unroll") for (int d0 = 1; d0 < 4; ++d0) { p0 = MFMA32(kf_[2 * d0], qr[d0], p0); p1 = MFMA32(kf_[2 * d0 + 1], qr[d0], p1); } \
        SB(); \
        if (__any(mhat != 0.f)) { _Pragma("unroll") for (int i = 0; i < 16; ++i) { p0[i] -= mhat; p1[i] -= mhat; } } } while (0)
#define ATT_MAX(j) do { \
        const int kpos0 = SAMPLE ? 64 * (j) : ((j) == 0 ? -16 : 64 * ((j) - 1)); \
        const bool partial = SAMPLE ? ((j) == 16) : ((j) == 0); \
        if (kpos0 + 63 - tq0 > -91 - 31 || partial) { \
            const int base = kpos0 - tq + 128 + 4 * hi; \
            _Pragma("unroll") for (int i = 0; i < 16; ++i) { const int kk = (i & 3) + 8 * (i >> 2); \
                int i0 = base + kk, i1 = base + kk + 32; i0 = i0 < 0 ? 0 : (i0 > 255 ? 255 : i0); i1 = i1 < 0 ? 0 : (i1 > 255 ? 255 : i1); \
                p0[i] += BT[i0]; p1[i] += BT[i1]; } } \
        if (partial) { _Pragma("unroll") for (int i = 0; i < 16; ++i) { if (crow(i, hi) >= 16) p0[i] = -INFINITY; p1[i] = -INFINITY; } } \
        float rm = fmaxf(fmaxf(p0[0], p0[1]), p1[0]), rm2 = fmaxf(fmaxf(p0[2], p0[3]), p1[1]); \
        _Pragma("unroll") for (int i = 4; i < 16; i += 4) { rm = fmaxf(fmaxf(rm, p0[i]), p0[i + 1]); rm2 = fmaxf(fmaxf(rm2, p0[i + 2]), p0[i + 3]); } \
        _Pragma("unroll") for (int i = 2; i < 16; i += 4) { rm = fmaxf(fmaxf(rm, p1[i]), p1[i + 1]); rm2 = fmaxf(fmaxf(rm2, p1[(i + 2) & 15]), p1[(i + 3) & 15]); } \
        rm = fmaxf(rm, rm2); \
        { auto rr_ = __builtin_amdgcn_permlane32_swap(__float_as_uint(rm), __float_as_uint(rm), false, false); rm = fmaxf(__uint_as_float(rr_[0]), __uint_as_float(rr_[1])); } \
        resc = false; \
        if (__any((j) == 0 ? (fabsf(rm) > 40.f) : (rm > 60.f))) { \
            const float dl = (j) == 0 ? (fabsf(rm) > 40.f ? rm : 0.f) : (rm > 60.f ? rm : 0.f); \
            mhat += dl; \
            _Pragma("unroll") for (int i = 0; i < 16; ++i) { p0[i] -= dl; p1[i] -= dl; } \
            if ((j) != 0) { rf = __builtin_amdgcn_exp2f(-dl); lsum *= rf; resc = true; } } \
    } while (0)
#define ATT_EXP(PF) do { float sa_ = 0.f, sb_ = 0.f; \
        _Pragma("unroll") for (int i = 0; i < 16; ++i) { p0[i] = __builtin_amdgcn_exp2f(p0[i]); p1[i] = __builtin_amdgcn_exp2f(p1[i]); sa_ += p0[i]; sb_ += p1[i]; } \
        lsum += sa_ + sb_; \
        PF[0] = pack_step(p0, 0); PF[1] = pack_step(p0, 1); PF[2] = pack_step(p1, 0); PF[3] = pack_step(p1, 1); \
    } while (0)
#define ATT_RESC() do { if (resc) { int hic = hi; asm volatile("" : "+v"(hic)); \
        _Pragma("unroll") for (int i = 0; i < 16; ++i) { const float fi = __shfl(rf, crow(i, hic)); \
            _Pragma("unroll") for (int e = 0; e < 4; ++e) o[e][i] *= fi; } } } while (0)
#define ATT_PV(PF, vs_) do { \
        LAS const unsigned char* vb = lds + (vs_) * A_STG + A_KSZ + (4 * hi + tq_) * A_RSV + (16 * blk + 4 * tp_) * 2; \
        _Pragma("unroll") for (int ks = 0; ks < 4; ++ks) { \
            _Pragma("unroll") for (int e = 0; e < 4; ++e) { \
                const v4s lo = tr16(vb + (16 * ks) * A_RSV + e * 64), hh = tr16(vb + (16 * ks + 8) * A_RSV + e * 64); \
                o[e] = MFMA32(PF[ks], cat4(lo, hh), o[e]); } } \
    } while (0)
#define VRD(F, ks) do { _Pragma("unroll") for (int e = 0; e < 4; ++e) { F[2 * e] = tr16(vb + (16 * (ks)) * A_RSV + e * 64); F[2 * e + 1] = tr16(vb + (16 * (ks) + 8) * A_RSV + e * 64); } } while (0)
#define EX2(i) do { p0[i] = __builtin_amdgcn_exp2f(p0[i]); p1[i] = __builtin_amdgcn_exp2f(p1[i]); sa_ += p0[i]; sb_ += p1[i]; } while (0)
#define PVG(PF, ks, F, X0, X1, X2, X3) do { \
        o[0] = MFMA32(PF[ks], cat4(F[0], F[1]), o[0]); X0; SB(); o[1] = MFMA32(PF[ks], cat4(F[2], F[3]), o[1]); X1; SB(); \
        o[2] = MFMA32(PF[ks], cat4(F[4], F[5]), o[2]); X2; SB(); o[3] = MFMA32(PF[ks], cat4(F[6], F[7]), o[3]); X3; SB(); } while (0)
#define ATT_PV_EXP(PF, PFN, vs_) do { \
        LAS const unsigned char* vb = lds + (vs_) * A_STG + A_KSZ + (4 * hi + tq_) * A_RSV + (16 * blk + 4 * tp_) * 2; \
        v4s fa[8], fb[8]; float sa_ = 0.f, sb_ = 0.f; \
        SB(); VRD(fa, 0); SB(); VRD(fb, 1); SB(); \
        PVG(PF, 0, fa, EX2(0), EX2(1), EX2(2), EX2(3)); VRD(fa, 2); SB(); \
        PVG(PF, 1, fb, EX2(4), EX2(5), EX2(6), EX2(7)); VRD(fb, 3); SB(); \
        PVG(PF, 2, fa, EX2(8), do { EX2(9); PFN[0] = pack_step(p0, 0); } while (0), EX2(10), do { EX2(11); PFN[2] = pack_step(p1, 0); } while (0)); \
        PVG(PF, 3, fb, EX2(12), EX2(13), EX2(14), EX2(15)); \
        PFN[1] = pack_step(p0, 1); PFN[3] = pack_step(p1, 1); lsum += sa_ + sb_; \
    } while (0)
#define ATT_ITER(j, PFC, PFN, sv_, sk_) do { \
        if (!SAMPLE) { if ((j) + 2 < ntiles) load_kv((j) + 2, true); if ((j) + 1 < ntiles) load_kv((j) + 1, false); } \
        if (active && (j) < ntw) { \
            if ((j) + 1 < ntw) { \
                QK_TILE(sk_); SB(); \
                ATT_MAX((j) + 1); \
                SB(); \
                ATT_PV_EXP(PFC, PFN, sv_); \
                ATT_RESC(); \
            } else { ATT_PV(PFC, sv_); } \
        } \
        if (SAMPLE) { if ((j) + 2 < ntiles) load_kv((j) + 2, true); if ((j) + 1 < ntiles) load_kv((j) + 1, false); } \
        if ((j) + 2 < ntiles) store_k(sv_); \
        if ((j) + 1 < ntiles) store_v(sk_); \
        __syncthreads(); \
    } while (0)
    load_kv(0, true); load_kv(0, false); store_k(0); store_v(0);
    load_kv(1, true); store_k(1);
    __syncthreads();
    bool resc = false; float rf = 1.f;
    if (active) { QK_TILE(0); ATT_MAX(0); ATT_EXP(pfa); }
    for (int j = 0; j < ntiles; j += 2) {
        ATT_ITER(j, pfa, pfb, 0, 1);
        if (j + 1 < ntiles) ATT_ITER(j + 1, pfb, pfa, 1, 0);
    }
#undef ATT_ITER
#undef ATT_MAX
#undef ATT_EXP
#undef ATT_RESC
#undef ATT_PV
#undef ATT_PV_EXP
#undef PVG
#undef EX2
#undef VRD
#undef SB
#undef QK_TILE
    const int lane2 = fresh_tid(wave_s) & 63, r32b = lane2 & 31, hib = lane2 >> 5;
    LAS float* X = (LAS float*)lds;
    if (active) {
        const int lane_f = lane2;
        float lam;
        { const float a = c.lq1[lane_f] * c.lk1[lane_f], bb = c.lq2[lane_f] * c.lk2[lane_f]; lam = __expf(wave_sum(a)) - __expf(wave_sum(bb)) + 0.2f; }
        lsum += __shfl_xor(lsum, 32);
        const float inv = (mp ? lam : 1.f) / lsum;
#pragma unroll
        for (int i = 0; i < 16; ++i) { const float fi = __shfl(inv, crow(i, hib));
#pragma unroll
            for (int e = 0; e < 4; ++e) o[e][i] *= fi; }
        if (mp) {
#pragma unroll
            for (int e = 0; e < 4; ++e)
#pragma unroll
                for (int i = 0; i < 16; ++i) X[(g * 64 + e * 16 + i) * 64 + lane2] = o[e][i];
        }
    }
    __syncthreads();
    if (active && !mp) {
        bf16* Y = (bf16*)(ws + WS_YD);
        float sg[4];
#pragma unroll
        for (int e = 0; e < 4; ++e) sg[e] = c.subg[32 * e + r32b] * 0.8f;
#pragma unroll
        for (int i = 0; i < 16; ++i) {
            float ss = 0.f;
#pragma unroll
            for (int e = 0; e < 4; ++e) { o[e][i] -= X[(g * 64 + e * 16 + i) * 64 + lane2]; ss += o[e][i] * o[e][i]; }
            ss += __shfl_xor(ss, 1); ss += __shfl_xor(ss, 2); ss += __shfl_xor(ss, 4); ss += __shfl_xor(ss, 8); ss += __shfl_xor(ss, 16);
            const float rstd = 1.f / sqrtf(ss * (1.f / 128.f) + 1e-5f);
            const int ql = crow(i, hib);
            if (STORE && (!SAMPLE || ql < 16)) {
                const size_t row = SAMPLE ? (size_t)ROW_S0 + b * 16 + ql : (size_t)b * SEQ + tq0 + ql;
#pragma unroll
                for (int e = 0; e < 4; ++e) Y[row * D + h * 128 + 32 * e + r32b] = (bf16)f2bf(o[e][i] * rstd * sg[e]); }
        }
    }
    __syncthreads();
}

constexpr int B_RSV = 288, B_VSZ = 64 * B_RSV, B_STG = A_KSZ + B_VSZ, B_BT = 2 * B_STG, B_END = B_BT + 1024;
static_assert(B_END <= LDS_MISC && B_STG * 2 >= 65536, "16x16 attention scratch");
#define MFMA16(a, b, c) __builtin_amdgcn_mfma_f32_16x16x32_bf16((a), (b), (c), 0, 0, 0)
template <bool SAMPLE> __device__ __forceinline__ void attn_unit16(const Ctx& c, LAS unsigned char* lds, int b, int h, int qb, int wave_s) {
    const int tid = fresh_tid(wave_s);
    const int lane = tid & 63, wid = __builtin_amdgcn_readfirstlane(tid >> 6), c16 = lane & 15, q4 = lane >> 4;
    const int g = ((wid >> 1) + 2) & 3, mp = wid & 1;
    const bool active = SAMPLE ? (g == 0) : true;
    constexpr int NQT = SAMPLE ? 1 : 2;
    unsigned char* ws = c.ws;
    LAS float* BT = (LAS float*)(lds + B_BT);
    if (tid < 256) { const int rel = tid - 128; BT[tid] = (c.rel_bias[t5_bucket(rel) * 8 + h] - c.rel_bias[15 * 8 + h]) * LOG2E; }
    const int tq0 = SAMPLE ? PAST : 128 * qb + 32 * g;
    const int ntiles = SAMPLE ? 17 : 2 * qb + 3;
    const int ntw = SAMPLE ? 17 : (tq0 >> 6) + 2;
    bf16x8 qr[2][2];
#pragma unroll
    for (int qt = 0; qt < NQT; ++qt) { const size_t qrow = SAMPLE ? (size_t)ROW_S0 + b * 16 + c16 : (size_t)b * SEQ + tq0 + 16 * qt + c16;
        const bf16* Q = (const bf16*)(ws + WS_DQ) + qrow * D + h * 128 + mp * 64 + q4 * 8;
        qr[qt][0] = *(const bf16x8*)Q; qr[qt][1] = *(const bf16x8*)(Q + 32); }
    const int lrow = tid >> 3, lck = tid & 7;
    u32x4 kreg[2], vreg[2];
    f32x4 kraw[4], vraw[4]; bool kok = true, vok = true;
    auto load_kv = [&](int j, bool isk) {
        u32x4 r0, r1;
        if (SAMPLE) {
            const float* p; bool ok = true;
            if (j < 16) { const size_t rr = ((size_t)b * PAST + 64 * j + lrow) * 8 + h; p = (isk ? c.cache_k : c.cache_v) + rr * 128; }
            else { ok = lrow < 16; const size_t rr = ((size_t)b * 16 + (lrow & 15)) * 8 + h; p = c.out + (isk ? O_KS : O_VS) + rr * 128; }
            if (isk) { kraw[0] = __builtin_nontemporal_load((const f32x4*)(p + lck * 8)); kraw[1] = __builtin_nontemporal_load((const f32x4*)(p + lck * 8 + 4)); kraw[2] = __builtin_nontemporal_load((const f32x4*)(p + 64 + lck * 8)); kraw[3] = __builtin_nontemporal_load((const f32x4*)(p + 64 + lck * 8 + 4)); kok = ok; }
            else     { vraw[0] = __builtin_nontemporal_load((const f32x4*)(p + lck * 8)); vraw[1] = __builtin_nontemporal_load((const f32x4*)(p + lck * 8 + 4)); vraw[2] = __builtin_nontemporal_load((const f32x4*)(p + 64 + lck * 8)); vraw[3] = __builtin_nontemporal_load((const f32x4*)(p + 64 + lck * 8 + 4)); vok = ok; }
            return;
        }
        if (!SAMPLE) {
            const int kidx0 = j == 0 ? 0 : 16 + 64 * (j - 1);
            const size_t rr = (size_t)(b * 8 + h) * KROWS + kidx0 + lrow;
            const bf16* p = (const bf16*)(ws + (isk ? WS_DK : WS_DV)) + rr * 128;
            r0 = *(const u32x4*)(p + lck * 8); r1 = *(const u32x4*)(p + 64 + lck * 8);
        } else {
            const float* p; bool ok = true;
            if (j < 16) { const size_t rr = ((size_t)b * PAST + 64 * j + lrow) * 8 + h; p = (isk ? c.cache_k : c.cache_v) + rr * 128; }
            else { ok = lrow < 16; const size_t rr = ((size_t)b * 16 + (lrow & 15)) * 8 + h; p = c.out + (isk ? O_KS : O_VS) + rr * 128; }
            r0 = pack8(*(const f32x4*)(p + lck * 8), *(const f32x4*)(p + lck * 8 + 4)); r1 = pack8(*(const f32x4*)(p + 64 + lck * 8), *(const f32x4*)(p + 64 + lck * 8 + 4));
            if (!ok) { r0 = (u32x4){0u, 0u, 0u, 0u}; r1 = r0; }
        }
        if (isk) { kreg[0] = r0; kreg[1] = r1; } else { vreg[0] = r0; vreg[1] = r1; }
    };
    auto store_k = [&](int slot) { if (SAMPLE) { kreg[0] = pack8(kraw[0], kraw[1]); kreg[1] = pack8(kraw[2], kraw[3]); if (!kok) { kreg[0] = (u32x4){0u, 0u, 0u, 0u}; kreg[1] = kreg[0]; } }
        LAS unsigned char* kb = lds + slot * B_STG + lrow * A_RSK + lck * 16; *(LAS u32x4*)kb = kreg[0]; *(LAS u32x4*)(kb + 128) = kreg[1]; };
    auto store_v = [&](int slot) { if (SAMPLE) { vreg[0] = pack8(vraw[0], vraw[1]); vreg[1] = pack8(vraw[2], vraw[3]); if (!vok) { vreg[0] = (u32x4){0u, 0u, 0u, 0u}; vreg[1] = vreg[0]; } }
        LAS unsigned char* vb = lds + slot * B_STG + A_KSZ + lrow * B_RSV + lck * 16; *(LAS u32x4*)vb = vreg[0]; *(LAS u32x4*)(vb + 128) = vreg[1]; };
    f32x4 o[2][8], p[2][4];
#pragma unroll
    for (int qt = 0; qt < NQT; ++qt)
#pragma unroll
        for (int et = 0; et < 8; ++et) o[qt][et] = (f32x4){0.f, 0.f, 0.f, 0.f};
    float ls[2] = {0.f, 0.f}, mh[2] = {0.f, 0.f}, rf[2] = {1.f, 1.f};
    bool resc = false;
    bf16x8 pfa[2][2], pfb[2][2];
    const int tq_ = c16 >> 2, tp_ = c16 & 3;
    const f32x4 zero4 = {0.f, 0.f, 0.f, 0.f};
#define SB() __builtin_amdgcn_sched_barrier(0)
#define QK16(ks_) do { LAS const unsigned char* kb_ = lds + (ks_) * B_STG + mp * 128 + c16 * A_RSK + q4 * 16; bf16x8 kf_[4][2]; \
        SB(); \
        _Pragma("unroll") for (int kt = 0; kt < 4; ++kt) { kf_[kt][0] = *(LAS const bf16x8*)(kb_ + kt * 16 * A_RSK); kf_[kt][1] = *(LAS const bf16x8*)(kb_ + kt * 16 * A_RSK + 64); } \
        SB(); \
        _Pragma("unroll") for (int kt = 0; kt < 4; ++kt) _Pragma("unroll") for (int qt = 0; qt < NQT; ++qt) p[qt][kt] = MFMA16(kf_[kt][0], qr[qt][0], zero4); \
        _Pragma("unroll") for (int kt = 0; kt < 4; ++kt) _Pragma("unroll") for (int qt = 0; qt < NQT; ++qt) p[qt][kt] = MFMA16(kf_[kt][1], qr[qt][1], p[qt][kt]); \
        SB(); \
        if (__any(mh[0] != 0.f || (NQT > 1 && mh[1] != 0.f))) { _Pragma("unroll") for (int qt = 0; qt < NQT; ++qt) _Pragma("unroll") for (int kt = 0; kt < 4; ++kt) p[qt][kt] = p[qt][kt] - mh[qt]; } } while (0)
#define MAX16(j) do { \
        const int kpos0 = SAMPLE ? 64 * (j) : ((j) == 0 ? -16 : 64 * ((j) - 1)); \
        const bool partial = SAMPLE ? ((j) == 16) : ((j) == 0); \
        if (kpos0 + 63 - tq0 > -91 - 31 || partial) { \
            _Pragma("unroll") for (int qt = 0; qt < NQT; ++qt) { const int tqv = SAMPLE ? PAST + c16 : tq0 + 16 * qt + c16; const int base = kpos0 - tqv + 128 + 4 * q4; \
                _Pragma("unroll") for (int kt = 0; kt < 4; ++kt) _Pragma("unroll") for (int i = 0; i < 4; ++i) { int ix = base + 16 * kt + i; ix = ix < 0 ? 0 : (ix > 255 ? 255 : ix); p[qt][kt][i] += BT[ix]; } } } \
        if (partial) { _Pragma("unroll") for (int qt = 0; qt < NQT; ++qt) _Pragma("unroll") for (int kt = 1; kt < 4; ++kt) p[qt][kt] = (f32x4){-INFINITY, -INFINITY, -INFINITY, -INFINITY}; } \
        float m_[2] = {0.f, 0.f}; \
        _Pragma("unroll") for (int qt = 0; qt < NQT; ++qt) { float a_ = fmaxf(fmaxf(p[qt][0][0], p[qt][0][1]), p[qt][0][2]), b_ = fmaxf(fmaxf(p[qt][0][3], p[qt][1][0]), p[qt][1][1]); \
            a_ = fmaxf(fmaxf(a_, p[qt][1][2]), p[qt][1][3]); b_ = fmaxf(fmaxf(b_, p[qt][2][0]), p[qt][2][1]); a_ = fmaxf(fmaxf(a_, p[qt][2][2]), p[qt][2][3]); \
            b_ = fmaxf(fmaxf(b_, p[qt][3][0]), p[qt][3][1]); a_ = fmaxf(fmaxf(a_, p[qt][3][2]), p[qt][3][3]); m_[qt] = fmaxf(a_, b_); } \
        resc = false; \
        const float mm_ = NQT > 1 ? fmaxf(m_[0], m_[1]) : m_[0]; \
        if (__any((j) == 0 ? (fabsf(m_[0]) > 40.f || (NQT > 1 && fabsf(m_[1]) > 40.f)) : (mm_ > 60.f))) { \
            _Pragma("unroll") for (int qt = 0; qt < NQT; ++qt) { float rm = fmaxf(m_[qt], __shfl_xor(m_[qt], 16)); rm = fmaxf(rm, __shfl_xor(rm, 32)); \
                const float dl = (j) == 0 ? (fabsf(rm) > 40.f ? rm : 0.f) : (rm > 60.f ? rm : 0.f); \
                mh[qt] += dl; \
                _Pragma("unroll") for (int kt = 0; kt < 4; ++kt) p[qt][kt] = p[qt][kt] - dl; \
                rf[qt] = __builtin_amdgcn_exp2f(-dl); if ((j) != 0) ls[qt] *= rf[qt]; } \
            resc = (j) != 0; } \
    } while (0)
#define EXP1(s_) do { const int qt_ = (s_) >> 4, kt_ = ((s_) >> 2) & 3, i_ = (s_) & 3; p[qt_][kt_][i_] = __builtin_amdgcn_exp2f(p[qt_][kt_][i_]); ls[qt_] += p[qt_][kt_][i_]; } while (0)
#define PACK16(PF, qt_, kp_) do { u32x4 w_; w_.x = cvt_pk_bf16(p[qt_][2 * (kp_)][0], p[qt_][2 * (kp_)][1]); w_.y = cvt_pk_bf16(p[qt_][2 * (kp_)][2], p[qt_][2 * (kp_)][3]); \
        w_.z = cvt_pk_bf16(p[qt_][2 * (kp_) + 1][0], p[qt_][2 * (kp_) + 1][1]); w_.w = cvt_pk_bf16(p[qt_][2 * (kp_) + 1][2], p[qt_][2 * (kp_) + 1][3]); PF[qt_][kp_] = __builtin_bit_cast(bf16x8, w_); } while (0)
#define EXPALL(PF) do { _Pragma("unroll") for (int s_ = 0; s_ < 16 * NQT; ++s_) EXP1(s_); PACK16(PF, 0, 0); PACK16(PF, 0, 1); if (NQT > 1) { PACK16(PF, 1, 0); PACK16(PF, 1, 1); } } while (0)
#define VRD16(F, kp_, eh_) do { _Pragma("unroll") for (int e4 = 0; e4 < 4; ++e4) { F[2 * e4] = tr16(vb + (32 * (kp_)) * B_RSV + (4 * (eh_) + e4) * 32); F[2 * e4 + 1] = tr16(vb + (32 * (kp_) + 16) * B_RSV + (4 * (eh_) + e4) * 32); } } while (0)
#define PVG16(PF, kp_, eh_, F, WITHX, sb_) do { _Pragma("unroll") for (int e4 = 0; e4 < 4; ++e4) _Pragma("unroll") for (int qt = 0; qt < NQT; ++qt) { \
        o[qt][4 * (eh_) + e4] = MFMA16(PF[qt][kp_], cat4(F[2 * e4], F[2 * e4 + 1]), o[qt][4 * (eh_) + e4]); if (WITHX) EXP1((sb_) + 2 * e4 + qt); SB(); } } while (0)
#define PV16(PF, PFN, vs_, WITHX) do { \
        LAS const unsigned char* vb = lds + (vs_) * B_STG + A_KSZ + (4 * q4 + tq_) * B_RSV + tp_ * 8; \
        v4s fa[8]; \
        SB(); VRD16(fa, 0, 0); SB(); \
        PVG16(PF, 0, 0, fa, WITHX, 0); VRD16(fa, 0, 1); if (WITHX) PACK16(PFN, 0, 0); SB(); \
        PVG16(PF, 0, 1, fa, WITHX, 8); VRD16(fa, 1, 0); if (WITHX) PACK16(PFN, 0, 1); SB(); \
        PVG16(PF, 1, 0, fa, WITHX, 16); VRD16(fa, 1, 1); if (WITHX) PACK16(PFN, 1, 0); SB(); \
        PVG16(PF, 1, 1, fa, WITHX, 24); if (WITHX) PACK16(PFN, 1, 1); SB(); \
    } while (0)
#define RESC16() do { if (resc) { int q4c = q4; asm volatile("" : "+v"(q4c)); \
        _Pragma("unroll") for (int qt = 0; qt < NQT; ++qt) _Pragma("unroll") for (int i = 0; i < 4; ++i) { const float fi = __shfl(rf[qt], 4 * q4c + i); \
            _Pragma("unroll") for (int et = 0; et < 8; ++et) o[qt][et][i] *= fi; } } } while (0)
#define ITER16(j, PFC, PFN, sv_, sk_) do { \
        { if ((j) + 2 < ntiles) load_kv((j) + 2, true); if ((j) + 1 < ntiles) load_kv((j) + 1, false); } \
        if (active && (j) < ntw) { \
            if ((j) + 1 < ntw) { QK16(sk_); MAX16((j) + 1); SB(); if (SAMPLE) { PV16(PFC, PFN, sv_, false); EXPALL(PFN); } else { PV16(PFC, PFN, sv_, true); } RESC16(); } \
            else { PV16(PFC, PFN, sv_, false); } \
        } \
        if ((j) + 2 < ntiles) store_k(sv_); \
        if ((j) + 1 < ntiles) store_v(sk_); \
        __syncthreads(); \
    } while (0)
    if (SAMPLE) { load_kv(0, true); load_kv(0, false); store_k(0); store_v(0); load_kv(1, true); store_k(1); }
    else { load_kv(0, true); const u32x4 k0a = kreg[0], k0b = kreg[1];
      load_kv(0, false); load_kv(1, true);
      LAS unsigned char* kb0 = lds + lrow * A_RSK + lck * 16; *(LAS u32x4*)kb0 = k0a; *(LAS u32x4*)(kb0 + 128) = k0b;
      store_v(0); store_k(1); }
    __syncthreads();
    if (active) { QK16(0); MAX16(0); EXPALL(pfa); }
    for (int j = 0; j < ntiles; j += 2) {
        ITER16(j, pfa, pfb, 0, 1);
        if (j + 1 < ntiles) ITER16(j + 1, pfb, pfa, 1, 0);
    }
#undef ITER16
#undef RESC16
#undef PV16
#undef PVG16
#undef VRD16
#undef EXPALL
#undef PACK16
#undef EXP1
#undef MAX16
#undef QK16
#undef SB
    const int lane2 = fresh_tid(wave_s) & 63, c16b = lane2 & 15, q4b = lane2 >> 4;
    LAS float* X = (LAS float*)lds;
    if (active) {
        float lam;
        { const float a = c.lq1[lane2] * c.lk1[lane2], bb = c.lq2[lane2] * c.lk2[lane2]; lam = __expf(wave_sum(a)) - __expf(wave_sum(bb)) + 0.2f; }
#pragma unroll
        for (int qt = 0; qt < NQT; ++qt) { float l = ls[qt] + __shfl_xor(ls[qt], 16); l += __shfl_xor(l, 32);
            const float inv = (mp ? lam : 1.f) / l;
#pragma unroll
            for (int i = 0; i < 4; ++i) { const float fi = __shfl(inv, 4 * q4b + i);
#pragma unroll
                for (int et = 0; et < 8; ++et) o[qt][et][i] *= fi; } }
        if (mp) {
#pragma unroll
            for (int qt = 0; qt < NQT; ++qt)
#pragma unroll
                for (int et = 0; et < 8; ++et)
#pragma unroll
                    for (int i = 0; i < 4; ++i) X[(g * 64 + qt * 32 + et * 4 + i) * 64 + lane2] = o[qt][et][i];
        }
    }
    __syncthreads();
    if (active && !mp) {
        bf16* Y = (bf16*)(ws + WS_YD);
        float sg[8];
#pragma unroll
        for (int et = 0; et < 8; ++et) sg[et] = c.subg[16 * et + c16b] * 0.8f;
#pragma unroll
        for (int qt = 0; qt < (SAMPLE ? 1 : 2); ++qt)
#pragma unroll
            for (int i = 0; i < 4; ++i) {
                float ss = 0.f;
#pragma unroll
                for (int et = 0; et < 8; ++et) { o[qt][et][i] -= X[(g * 64 + qt * 32 + et * 4 + i) * 64 + lane2]; ss += o[qt][et][i] * o[qt][et][i]; }
                ss += __shfl_xor(ss, 1); ss += __shfl_xor(ss, 2); ss += __shfl_xor(ss, 4); ss += __shfl_xor(ss, 8);
                const float rstd = 1.f / sqrtf(ss * (1.f / 128.f) + 1e-5f);
                const int ql = 16 * qt + 4 * q4b + i;
                const size_t row = SAMPLE ? (size_t)ROW_S0 + b * 16 + ql : (size_t)b * SEQ + tq0 + ql;
#pragma unroll
                for (int et = 0; et < 8; ++et) Y[row * D + h * 128 + 16 * et + c16b] = (bf16)f2bf(o[qt][et][i] * rstd * sg[et]);
            }
    }
    __syncthreads();
}

constexpr int R_RSQ = 272, R_RSKP = 320, R_RSV = 576, R_RSP = 144, R_RSG = 528;
constexpr int R_Q = 0, R_K = R_Q + 64 * R_RSQ, R_KP = R_K + 64 * R_RSQ, R_V = R_KP + 64 * R_RSKP, R_P = R_V + 64 * R_RSV, R_PS = R_P + 64 * R_RSP, R_RST = R_PS + 2048, R_RG = R_RST + 256, R_END = R_RG + 64 * R_RSG;
static_assert(R_END <= LDS_MISC && A_END <= LDS_MISC, "phase scratch fits below the LDS control words");
constexpr int NSEG = 8, CPS = 128 / NSEG;
constexpr int CW_FLAGS = 9216;
template <int MODE, bool STORE = true> __device__ __forceinline__ void ret_unit(const Ctx& c, LAS unsigned char* lds, int b, int h, int seg, int wave_s) {
    constexpr bool SAMPLE = MODE == 1;
    const int tid = fresh_tid(wave_s);
    const int lane = tid & 63, w = __builtin_amdgcn_readfirstlane(tid >> 6), r32 = lane & 31, hi = lane >> 5;
    unsigned char* ws = c.ws;
    unsigned* ctl = (unsigned*)(ws + WS_CTL);
    const float lg2 = log2f(1.f - exp2f(-5.f - (float)h));
    constexpr int LCH = SAMPLE ? 16 : 64;
    const float gL = exp2f(lg2 * (float)LCH);
    const int nch = MODE == 1 ? 1 : (MODE == 0 ? CPS + 1 : CPS);
    float* LS = (float*)(ws + WS_LS);
    f32x16 S[4];
    if (SAMPLE) { const float* sp = c.state_ret + ((size_t)(b * 4 + h) * 128 + 4 * hi) * 256 + 32 * w + r32;
#pragma unroll
        for (int dt = 0; dt < 4; ++dt) {
            __builtin_amdgcn_sched_barrier(0);
#pragma unroll
            for (int i = 0; i < 16; ++i) S[dt][i] = sp[(32 * dt + crow(i, 0)) * 256]; }
    } else {
#pragma unroll
        for (int dt = 0; dt < 4; ++dt)
#pragma unroll
            for (int i = 0; i < 16; ++i) S[dt][i] = 0.f;
    }
    const int lrow = tid >> 3, lck = tid & 7;
    u32x4 qreg[2], kreg[2], vreg[4], greg[4];
    auto chunk_row = [&](int ch, bool& ok) -> size_t {
        ok = true;
        if (SAMPLE) { ok = lrow < 16; return (size_t)ROW_S0 + b * 16 + (lrow & 15); }
        if (MODE == 0 && ch == 0) { ok = lrow < 16; return (size_t)ROW_M0 + (lrow & 15); }
        return (size_t)b * SEQ + 64 * (seg * CPS + (MODE == 0 ? ch - 1 : ch)) + lrow;
    };
    auto load_chunk = [&](int ch) {
        bool ok; const size_t row = chunk_row(ch, ok);
        const bf16* qp = (const bf16*)(ws + WS_QR) + row * 512 + h * 128; const bf16* kp = (const bf16*)(ws + WS_KR) + row * 512 + h * 128; const bf16* vp = (const bf16*)(ws + WS_VR) + row * D + h * 256;
#pragma unroll
        for (int t = 0; t < 2; ++t) { if (MODE != 2) qreg[t] = *(const u32x4*)(qp + t * 64 + lck * 8); kreg[t] = *(const u32x4*)(kp + t * 64 + lck * 8); }
#pragma unroll
        for (int t = 0; t < 4; ++t) vreg[t] = *(const u32x4*)(vp + t * 64 + lck * 8);
        if (!ok) {
#pragma unroll
            for (int t = 0; t < 2; ++t) { qreg[t] = (u32x4){0u, 0u, 0u, 0u}; kreg[t] = (u32x4){0u, 0u, 0u, 0u}; }
#pragma unroll
            for (int t = 0; t < 4; ++t) vreg[t] = (u32x4){0u, 0u, 0u, 0u}; }
    };
    auto store_chunk = [&](int ch) {
        const bool short_ch = SAMPLE || (MODE == 0 && ch == 0);
        const float kd = exp2f(lg2 * (float)((short_ch ? 15 : 63) - lrow));
#pragma unroll
        for (int t = 0; t < 2; ++t) {
            if (MODE != 2) { *(LAS u32x4*)(lds + R_Q + lrow * R_RSQ + t * 128 + lck * 16) = qreg[t];
                             *(LAS u32x4*)(lds + R_K + lrow * R_RSQ + t * 128 + lck * 16) = kreg[t]; }
            float f[8]; unpack8(kreg[t], f); u32x4 kp;
            kp.x = cvt_pk_bf16(f[0] * kd, f[1] * kd); kp.y = cvt_pk_bf16(f[2] * kd, f[3] * kd); kp.z = cvt_pk_bf16(f[4] * kd, f[5] * kd); kp.w = cvt_pk_bf16(f[6] * kd, f[7] * kd);
            *(LAS u32x4*)(lds + R_KP + lrow * R_RSKP + t * 128 + lck * 16) = kp; }
#pragma unroll
        for (int t = 0; t < 4; ++t) *(LAS u32x4*)(lds + R_V + lrow * R_RSV + t * 128 + lck * 16) = vreg[t];
    };
    const int i16 = lane & 15, tq_ = i16 >> 2, tp_ = i16 & 3, blk = (lane >> 4) & 1;
    load_chunk(0); store_chunk(0);
    __syncthreads();
    for (int ch = 0; ch < nch; ++ch) {
        const bool state_only = MODE == 2 || (MODE == 0 && ch == 0);
        float lgc = lg2; int hic = hi, r32c = r32; asm volatile("" : "+v"(lgc), "+v"(hic), "+v"(r32c));
        f32x16 O[2];
        bf16x8 vf[4];
        { LAS const unsigned char* vb = lds + R_V + (8 * hi + tq_) * R_RSV + (32 * w + 16 * blk + 4 * tp_) * 2;
#pragma unroll
          for (int s = 0; s < 4; ++s) vf[s] = cat4(tr16(vb + (16 * s) * R_RSV), tr16(vb + (16 * s + 4) * R_RSV)); }
        if (!state_only) {
            if (w < 4) { const int mt = w >> 1, lt = w & 1; f32x16 x;
#pragma unroll
                for (int i = 0; i < 16; ++i) x[i] = 0.f;
                LAS const unsigned char* ka = lds + R_K + (32 * mt + r32) * R_RSQ + hi * 16; LAS const unsigned char* qb_ = lds + R_Q + (32 * lt + r32) * R_RSQ + hi * 16;
#pragma unroll
                for (int s = 0; s < 8; ++s) { if ((s & 3) == 0) __builtin_amdgcn_sched_barrier(0); x = MFMA32(*(LAS const bf16x8*)(ka + 32 * s), *(LAS const bf16x8*)(qb_ + 32 * s), x); }
                const int l = 32 * lt + r32c;
#pragma unroll
                for (int i = 0; i < 16; ++i) { const int m = 32 * mt + crow(i, hic); const int dlt = l > m ? l - m : m - l; x[i] *= __builtin_amdgcn_exp2f(lgc * (float)dlt); }
#pragma unroll
                for (int q4 = 0; q4 < 4; ++q4) { u32x2 pk; pk.x = cvt_pk_bf16(x[4 * q4], x[4 * q4 + 1]); pk.y = cvt_pk_bf16(x[4 * q4 + 2], x[4 * q4 + 3]);
                    *(LAS u32x2*)(lds + R_P + (32 * lt + r32) * R_RSP + (32 * mt + 8 * q4 + 4 * hi) * 2) = pk; }
            }
            __builtin_amdgcn_sched_barrier(0);
#pragma unroll
            for (int lt = 0; lt < 2; ++lt) {
#pragma unroll
                for (int i = 0; i < 16; ++i) O[lt][i] = 0.f; }
#pragma unroll
            for (int dt = 0; dt < 4; ++dt) {
                __builtin_amdgcn_sched_barrier(0);
#pragma unroll
                for (int s = 0; s < 2; ++s) { const bf16x8 sb = pack_step(S[dt], s);
#pragma unroll
                    for (int lt = 0; lt < 2; ++lt) { LAS const unsigned char* qa = lds + R_Q + (32 * lt + r32) * R_RSQ + (32 * dt + 16 * s + 4 * hi) * 2;
                        const v4s a0 = *(LAS const v4s*)qa, a1 = *(LAS const v4s*)(qa + 16);
                        O[lt] = MFMA32(cat4(a0, a1), sb, O[lt]); } } }
#pragma unroll
            for (int lt = 0; lt < 2; ++lt)
#pragma unroll
                for (int i = 0; i < 16; ++i) O[lt][i] *= __builtin_amdgcn_exp2f(lgc * (float)(32 * lt + crow(i, hic) + 1));
            __syncthreads();
#pragma unroll
            for (int lt = 0; lt < 2; ++lt) { LAS const unsigned char* pa = lds + R_P + (32 * lt + r32) * R_RSP + hi * 16;
#pragma unroll
                for (int s = 0; s < 4; ++s) O[lt] = MFMA32(*(LAS const bf16x8*)(pa + 32 * s), vf[s], O[lt]); }
        }
#pragma unroll
        for (int dt = 0; dt < 4; ++dt) {
            if ((dt & 1) == 0) __builtin_amdgcn_sched_barrier(0);
#pragma unroll
            for (int i = 0; i < 16; ++i) S[dt][i] *= gL;
            LAS const unsigned char* ka = lds + R_KP + (8 * hi + tq_) * R_RSKP + (32 * dt + 16 * blk + 4 * tp_) * 2;
#pragma unroll
            for (int s = 0; s < 4; ++s) S[dt] = MFMA32(cat4(tr16(ka + (16 * s) * R_RSKP), tr16(ka + (16 * s + 4) * R_RSKP)), vf[s], S[dt]); }
        __builtin_amdgcn_sched_barrier(0);
        if (ch + 1 < nch) load_chunk(ch + 1);
        if (!state_only) {
            { bool ok; const size_t row = chunk_row(ch, ok); const bf16* gp = (const bf16*)(ws + WS_RG) + row * D + h * 256;
#pragma unroll
              for (int t = 0; t < 4; ++t) greg[t] = __builtin_nontemporal_load((const u32x4*)(gp + t * 64 + lck * 8)); }
            __builtin_amdgcn_sched_barrier(0);
            LAS float* PS = (LAS float*)(lds + R_PS); LAS float* RST = (LAS float*)(lds + R_RST);
            { float v[32];
#pragma unroll
              for (int lt = 0; lt < 2; ++lt)
#pragma unroll
                  for (int i = 0; i < 16; ++i) v[lt * 16 + i] = O[lt][i] * O[lt][i];
#pragma unroll
              for (int st = 0; st < 5; ++st) { const int m = 16 >> st, n = 32 >> st; const bool up = (r32 & m) != 0;
#pragma unroll
                  for (int k = 0; k < n / 2; ++k) { const float send = up ? v[k] : v[k + n / 2], keep = up ? v[k + n / 2] : v[k]; v[k] = keep + __shfl_xor(send, m); } }
              PS[w * 64 + 32 * (r32 >> 4) + crow(r32 & 15, hi)] = v[0]; }
            __syncthreads();
            if (tid < 64) { float t = 0.f;
#pragma unroll
                for (int ww = 0; ww < 8; ++ww) t += PS[ww * 64 + tid];
                RST[tid] = 1.f / sqrtf(t * (1.f / 256.f) + 1e-6f); }
#pragma unroll
            for (int t = 0; t < 4; ++t) *(LAS u32x4*)(lds + R_RG + lrow * R_RSG + t * 128 + lck * 16) = greg[t];
            __syncthreads();
            LAS unsigned short* GT = (LAS unsigned short*)(lds + R_RG) + 32 * w + r32;
#pragma unroll
            for (int lt = 0; lt < 2; ++lt)
#pragma unroll
                for (int i = 0; i < 16; ++i) { const int l = 32 * lt + crow(i, hi);
                    GT[l * (R_RSG / 2)] = (unsigned short)f2bf(O[lt][i] * RST[l] * silu_f(bf2f(GT[l * (R_RSG / 2)]))); }
            __syncthreads();
            { bool ok; const size_t row = chunk_row(ch, ok); bf16* yp = (bf16*)(ws + WS_VR) + row * D + h * 256;
              if (ok && STORE) {
#pragma unroll
                  for (int t = 0; t < 4; ++t) __builtin_nontemporal_store(*(LAS const u32x4*)(lds + R_RG + lrow * R_RSG + t * 128 + lck * 16), (u32x4*)(yp + t * 64 + lck * 8)); } }
        } else {
            __syncthreads();
        }
        if (MODE == 0 && ch == 0 && seg > 0) {
            if (tid == 0) {
                for (int sp = 0; sp < seg; ++sp) { unsigned* fl = ctl + CW_FLAGS + (b * 4 + h) * 16 + sp; unsigned spin = 0;
                    while (__hip_atomic_load(fl, __ATOMIC_RELAXED, __HIP_MEMORY_SCOPE_AGENT) == 0u) { __builtin_amdgcn_s_sleep(2); if (++spin > (1u << 24)) break; } }
                __builtin_amdgcn_fence(__ATOMIC_ACQUIRE, "agent");
                asm volatile("s_waitcnt vmcnt(0)" ::: "memory");
            }
            __syncthreads();
            const float gS = exp2f(lg2 * (float)(64 * CPS) * (float)seg);
#pragma unroll
            for (int dt = 0; dt < 4; ++dt)
#pragma unroll
                for (int i = 0; i < 16; ++i) S[dt][i] *= gS;
            for (int sp = 0; sp < seg; ++sp) {
                const float cf = exp2f(lg2 * (float)(64 * CPS) * (float)(seg - 1 - sp));
                if (cf < 1e-12f) continue;
                const float* L = LS + ((size_t)((b * 4 + h) * NSEG + sp)) * 32768 + w * 64 + lane;
                f32x16 t[4];
#pragma unroll
                for (int dt = 0; dt < 4; ++dt)
#pragma unroll
                    for (int i = 0; i < 16; ++i) t[dt][i] = __builtin_nontemporal_load(L + (dt * 16 + i) * 512);
#pragma unroll
                for (int dt = 0; dt < 4; ++dt)
#pragma unroll
                    for (int i = 0; i < 16; ++i) S[dt][i] += cf * t[dt][i];
            }
        }
        if (ch + 1 < nch) { store_chunk(ch + 1); __syncthreads(); }
    }
    if (!STORE) { __syncthreads(); return; }
    if (MODE == 2) {
        float* L = LS + ((size_t)((b * 4 + h) * NSEG + seg)) * 32768 + w * 64 + lane;
#pragma unroll
        for (int dt = 0; dt < 4; ++dt)
#pragma unroll
            for (int i = 0; i < 16; ++i) L[(dt * 16 + i) * 512] = S[dt][i];
        asm volatile("s_waitcnt vmcnt(0)" ::: "memory");
        __syncthreads();
        if (tid == 0) { __builtin_amdgcn_fence(__ATOMIC_RELEASE, "agent"); asm volatile("s_waitcnt vmcnt(0)" ::: "memory");
            __hip_atomic_store(ctl + CW_FLAGS + (b * 4 + h) * 16 + seg, 1u, __ATOMIC_RELAXED, __HIP_MEMORY_SCOPE_AGENT); }
    } else if (SAMPLE || seg == NSEG - 1) {
        int hio = hi; asm volatile("" : "+v"(hio));
        float* so = c.out + (SAMPLE ? O_SS : O_SP) + ((size_t)(b * 4 + h) * 128 + 4 * hio) * 256 + 32 * w + r32;
#pragma unroll
        for (int dt = 0; dt < 4; ++dt) {
            __builtin_amdgcn_sched_barrier(0);
#pragma unroll
            for (int i = 0; i < 16; ++i) so[(32 * dt + crow(i, 0)) * 256] = S[dt][i]; }
    }
    __syncthreads();
}
__global__ void __launch_bounds__(512, 2) hybrid_fwd(Ctx c) {
    extern __shared__ __attribute__((aligned(16))) unsigned char lds_raw[];
    LAS unsigned char* lds = (LAS unsigned char*)lds_raw;
    const int wave0 = __builtin_amdgcn_readfirstlane(threadIdx.x >> 6);
    const int G = gridDim.x, bx = blockIdx.x, vcu = (G % 8 == 0) ? (bx % 8) * (G / 8) + bx / 8 : bx;
    volatile LAS unsigned* MISC = (volatile LAS unsigned*)(lds + LDS_MISC);
    { const int t0 = fresh_tid(wave0); if (t0 < 64) MISC[t0] = 0u; }
    __syncthreads();
    unsigned* ctl = (unsigned*)(c.ws + WS_CTL);
    XcdBarrier bar = xcd_barrier_post(ctl, MISC + 8, wave0);
    unsigned char* ws = c.ws;

    p0_prep(c, lds, vcu, G, wave0);
    if (G == 0x7fffffff) cg::this_grid().sync();
    xcd_barrier(bar);

#ifdef PROBE_G
    for (int rep_ = 0; rep_ < 2; ++rep_)
#endif
    { pg8::Gemm g{(const pg8::bf16_t*)(ws + WS_XN), (const pg8::bf16_t*)(ws + WS_WIN), R_ALL, 8192, D}; pg8::StaticOrder S; S.init(R_ALL, 8192, G, bx);
      EpiIn E{c}; pg8::gemm_phase<EpiIn, pg8::StaticOrder, true, true>(lds, g, S, E, wave0); }
    xcd_barrier(bar);

    {
        for (;;) {
            if (fresh_tid(wave0) == 0) MISC[16] = atomicAdd(ctl + CW_QUEUE, 1u);
            __syncthreads();
            const int it = (int)MISC[16];
            __syncthreads();
            if (it >= 432) break;
            if (it < 112) { const int bh = it / 7, sg = it % 7; ret_unit<2>(c, lds, bh >> 2, bh & 3, sg, wave0); }
            else if (it < 240) { const int k = it - 112, bh = k >> 3, sg = k & 7; ret_unit<0>(c, lds, bh >> 2, bh & 3, sg, wave0); }
            else if (it < 304) ret_unit<1>(c, lds, (it - 240) >> 2, (it - 240) & 3, 0, wave0);
            else attn_unit16<true>(c, lds, (it - 304) >> 3, (it - 304) & 7, 0, wave0);
        }
        const int x0 = (int)(xb_xcc_id() & 7u);
        for (int kx = 0; kx < 8; ++kx) {
            const int xq = (x0 + kx) & 7;
            for (;;) {
                if (fresh_tid(wave0) == 0) MISC[16] = atomicAdd(ctl + CW_XQ + 64 * xq, 1u);
                __syncthreads();
                const int it = (int)MISC[16];
                __syncthreads();
                if (it >= 128) break;
                const int bh = 4 * xq + (it >> 5), pp = it & 31;
#ifdef PROBE_A
                attn_unit<false, false>(c, lds, bh >> 3, bh & 7, 63 - pp, wave0);
                attn_unit<false, false>(c, lds, bh >> 3, bh & 7, pp, wave0);
#endif
                attn_unit16<false>(c, lds, bh >> 3, bh & 7, 63 - pp, wave0);
                attn_unit16<false>(c, lds, bh >> 3, bh & 7, pp, wave0);
            }
        }
    }
    xcd_barrier(bar);

    bf16* MG = (bf16*)(ws + WS_MG);
    for (int u = bx; u < 256; u += G) {
        const int rg = u & 7, cg = u >> 3;
        const bf16* const Bs[1] = {(const bf16*)(ws + WS_WRB) + (size_t)(32 * cg) * D};
        small_gemm<1>((const bf16*)(ws + WS_VR), D, Bs, rg, wave0, lds, [&](const float (&v)[1][2], int w, int r32, int hi) {
            const int col = 32 * cg + r32;
#pragma unroll
            for (int ii = 0; ii < 2; ++ii) { const int row = ROW_S0 + 32 * rg + crow(2 * w + ii, hi);
                MG[(size_t)row * D + col] = (bf16)f2bf(bf2f(gate_row(c, 0, row)[col]) * v[0][ii]); } });
    }
    { pg8::Gemm g{(const pg8::bf16_t*)(ws + WS_VR), (const pg8::bf16_t*)(ws + WS_WRB), ROW_S0, D, D}; pg8::StaticOrder S; S.init(ROW_S0, D, G, bx);
      EpiBranch<0> E{c}; pg8::gemm_phase<EpiBranch<0>, pg8::StaticOrder, true, true>(lds, g, S, E, wave0); }
    for (int u = bx; u < 256; u += G) {
        const int rg = u & 7, cg = u >> 3;
        const bf16* const Bs[1] = {(const bf16*)(ws + WS_WDB) + (size_t)(32 * cg) * D};
        small_gemm<1>((const bf16*)(ws + WS_YD), D, Bs, rg, wave0, lds, [&](const float (&v)[1][2], int w, int r32, int hi) {
            const int col = 32 * cg + r32;
#pragma unroll
            for (int ii = 0; ii < 2; ++ii) { const int row = ROW_S0 + 32 * rg + crow(2 * w + ii, hi); const size_t idx = (size_t)row * D + col;
                MG[idx] = (bf16)f2bf(bf2f(MG[idx]) + bf2f(gate_row(c, 1, row)[col]) * v[0][ii]); } });
    }
    { pg8::Gemm g{(const pg8::bf16_t*)(ws + WS_YD), (const pg8::bf16_t*)(ws + WS_WDB), ROW_S0, D, D}; pg8::StaticOrder S; S.init(ROW_S0, D, G, bx);
      EpiBranch<1> E{c}; pg8::gemm_phase<EpiBranch<1>, pg8::StaticOrder, true, true>(lds, g, S, E, wave0); }
    xcd_barrier(bar);
    for (int u = bx; u < 128; u += G) {
        const int rg = u & 7, cg = u >> 3;
        const bf16* const Bs[2] = {(const bf16*)(ws + WS_WO) + (size_t)(64 * cg) * D, (const bf16*)(ws + WS_WO) + (size_t)(64 * cg + 32) * D};
        small_gemm<2>((const bf16*)(ws + WS_MG), D, Bs, rg, wave0, lds, [&](const float (&v)[2][2], int w, int r32, int hi) {
            float* SS = (float*)(ws + WS_SS1); bf16* HB = (bf16*)(ws + WS_H1B);
#pragma unroll
            for (int ii = 0; ii < 2; ++ii) { const int sr = 32 * rg + crow(2 * w + ii, hi), row = ROW_S0 + sr; float ss = 0.f;
#pragma unroll
                for (int nb = 0; nb < 2; ++nb) { const int col = 64 * cg + 32 * nb + r32; const float x = c.x_sample[(size_t)sr * D + col] + v[nb][ii];
                    HB[(size_t)row * D + col] = (bf16)f2bf(x); ss += x * x; }
                ss += __shfl_xor(ss, 1); ss += __shfl_xor(ss, 2); ss += __shfl_xor(ss, 4); ss += __shfl_xor(ss, 8); ss += __shfl_xor(ss, 16);
                if (r32 == 0) SS[(size_t)row * 16 + cg] = ss; } });
    }
    { pg8::Gemm g{(const pg8::bf16_t*)(ws + WS_MG), (const pg8::bf16_t*)(ws + WS_WO), ROW_S0, D, D}; pg8::StaticOrder S; S.init(ROW_S0, D, G, bx);
      EpiResid<0> E{c}; pg8::gemm_phase<EpiResid<0>, pg8::StaticOrder, true, true>(lds, g, S, E, wave0); }
    xcd_barrier(bar);
    for (int u = bx; u < 8 * (DFF / 32); u += G) {
        const int rg = u & 7, cg = u >> 3;
        const int wrow = ((32 * cg) >> 7) * 256 + ((32 * cg) & 127);
        const bf16* const Bs[2] = {(const bf16*)(ws + WS_WUP) + (size_t)wrow * D, (const bf16*)(ws + WS_WUP) + (size_t)(wrow + 128) * D};
        small_gemm<2>((const bf16*)(ws + WS_H1B), D, Bs, rg, wave0, lds, [&](const float (&v)[2][2], int w, int r32, int hi) {
            const float* SS = (const float*)(ws + WS_SS1); bf16* HID = (bf16*)(ws + WS_HID);
#pragma unroll
            for (int ii = 0; ii < 2; ++ii) { const int row = ROW_S0 + 32 * rg + crow(2 * w + ii, hi); const f32x4* sp = (const f32x4*)(SS + (size_t)row * 16);
                const f32x4 a = sp[0], b = sp[1], cc = sp[2], dd = sp[3];
                const float tot = ((a[0] + a[1]) + (a[2] + a[3])) + ((b[0] + b[1]) + (b[2] + b[3])) + ((cc[0] + cc[1]) + (cc[2] + cc[3])) + ((dd[0] + dd[1]) + (dd[2] + dd[3]));
                const float rstd = 1.f / sqrtf(tot * (1.f / D) + 1e-6f);
                HID[(size_t)row * DFF + 32 * cg + r32] = (bf16)f2bf(silu_f(v[0][ii] * rstd) * (v[1][ii] * rstd)); } });
    }
    { pg8::Gemm g{(const pg8::bf16_t*)(ws + WS_H1B), (const pg8::bf16_t*)(ws + WS_WUP), ROW_S0, 2 * DFF, D}; pg8::StaticOrder S; S.init(ROW_S0, 2 * DFF, G, bx);
      EpiUp E{c}; pg8::gemm_phase<EpiUp, pg8::StaticOrder, true, true>(lds, g, S, E, wave0); }
    xcd_barrier(bar);
    for (int u = bx; u < 128; u += G) {
        const int rg = u & 7, cg = u >> 3;
        const bf16* const Bs[2] = {(const bf16*)(ws + WS_WDN) + (size_t)(64 * cg) * DFF, (const bf16*)(ws + WS_WDN) + (size_t)(64 * cg + 32) * DFF};
        small_gemm<2>((const bf16*)(ws + WS_HID), DFF, Bs, rg, wave0, lds, [&](const float (&v)[2][2], int w, int r32, int hi) {
            float* SS = (float*)(ws + WS_SS2);
#pragma unroll
            for (int ii = 0; ii < 2; ++ii) { const int sr = 32 * rg + crow(2 * w + ii, hi), row = ROW_S0 + sr; float ss = 0.f;
#pragma unroll
                for (int nb = 0; nb < 2; ++nb) { const size_t idx = (size_t)row * D + 64 * cg + 32 * nb + r32; const float x = bf2f(((const bf16*)(ws + WS_H1B))[idx]) + v[nb][ii]; ((bf16*)(ws + WS_H2B))[idx] = (bf16)f2bf(x); ss += x * x; }
                ss += __shfl_xor(ss, 1); ss += __shfl_xor(ss, 2); ss += __shfl_xor(ss, 4); ss += __shfl_xor(ss, 8); ss += __shfl_xor(ss, 16);
                if (r32 == 0) SS[(size_t)row * 16 + cg] = ss; } });
    }
    { pg8::Gemm g{(const pg8::bf16_t*)(ws + WS_HID), (const pg8::bf16_t*)(ws + WS_WDN), ROW_S0, D, DFF}; pg8::StaticOrder S; S.init(ROW_S0, D, G, bx);
      EpiResid<1> E{c}; pg8::gemm_phase<EpiResid<1>, pg8::StaticOrder, true, true>(lds, g, S, E, wave0); }
    xcd_barrier(bar);
    { const int tid_ = fresh_tid(wave0); const int lane = tid_ & 63, wave = wave0;
      const int gw = vcu * 8 + wave, NGW = G * 8; const float* SS = (const float*)(ws + WS_SS2); const bf16* H2 = (const bf16*)(ws + WS_H2B);
      for (int m = gw; m < R_TAIL; m += NGW) { float* y = yrow(c, m);
          const float part = lane < 16 ? SS[(size_t)m * 16 + lane] : 0.f;
          const float rstd = 1.f / sqrtf(wave_sum(part) * (1.f / D) + 1e-6f);
          const u32x4* hr = (const u32x4*)(H2 + (size_t)m * D) + lane; f32x4* yr = (f32x4*)y; const f32x4* gr = (const f32x4*)c.nfg;
#pragma unroll
          for (int j = 0; j < 2; ++j) { float hf[8]; unpack8(__builtin_nontemporal_load(hr + 64 * j), hf); const int q = 2 * (64 * j + lane);
              const f32x4 g0 = gr[q], g1 = gr[q + 1];
              __builtin_nontemporal_store((f32x4){hf[0], hf[1], hf[2], hf[3]} * rstd * g0, yr + q); __builtin_nontemporal_store((f32x4){hf[4], hf[5], hf[6], hf[7]} * rstd * g1, yr + q + 1); } } }
}

extern "C" void kernel_launch(void* const* d_in, const int* in_sizes, int n_in, void* d_out, int out_size, void* d_ws, size_t ws_size, hipStream_t stream) {
    static int grid = 0;
    if (grid == 0) {
        if (n_in != 21 || ws_size < WS_END) { fprintf(stderr, "kernel_launch: unexpected n_in %d / ws_size %zu (need %zu)\n", n_in, ws_size, (size_t)WS_END); grid = -1; return; }
        int dev = 0, cus = 0, per_cu = 0;
        if (hipGetDevice(&dev) != hipSuccess || hipDeviceGetAttribute(&cus, hipDeviceAttributeMultiprocessorCount, dev) != hipSuccess) { grid = -1; return; }
        if (hipFuncSetAttribute((const void*)hybrid_fwd, hipFuncAttributeMaxDynamicSharedMemorySize, LDS_BYTES) != hipSuccess) { fprintf(stderr, "kernel_launch: hipFuncSetAttribute failed\n"); grid = -1; return; }
        if (hipOccupancyMaxActiveBlocksPerMultiprocessor(&per_cu, (const void*)hybrid_fwd, 512, LDS_BYTES) != hipSuccess || per_cu < 1) { fprintf(stderr, "kernel_launch: occupancy query says %d\n", per_cu); per_cu = 1; }
        (void)hipGetLastError();
        grid = cus * 1;
    }
    if (grid < 0) return;
    (void)hipMemsetAsync((char*)d_ws + WS_CTL, 0, CTL_BYTES, stream);
    Ctx c{};
    const float** f = (const float**)&c;
    for (int i = 0; i < 21; ++i) f[i] = (const float*)d_in[i];
    c.out = (float*)d_out; c.ws = (unsigned char*)d_ws;
    void* args[] = {&c};
    hipError_t e = hipLaunchCooperativeKernel((const void*)hybrid_fwd, dim3(grid), dim3(512), args, LDS_BYTES, stream);
    if (e != hipSuccess) fprintf(stderr, "kernel_launch: cooperative launch failed: %s (grid %d)\n", hipGetErrorString(e), grid);
}
```

```cpp
#include <hip/hip_runtime.h>
#include <hip/hip_cooperative_groups.h>
#include <cstdio>
#include <cstdint>
namespace cg = cooperative_groups;
namespace pg8 {
#define PG8_LAS __attribute__((address_space(3)))
typedef unsigned short bf16_t;
typedef short bf16x8 __attribute__((ext_vector_type(8)));
typedef float f32x4 __attribute__((ext_vector_type(4)));
typedef unsigned u32x4 __attribute__((ext_vector_type(4)));
constexpr int BM = 256, BK = 64, HALF = 128, HTB = HALF * BK * 2  , STAGE_BYTES = 8 * HTB, NXCD = 8, WGM = 8;

__host__ __device__ __forceinline__ int lds_byte(int r, int c) { const int st = (r >> 4) * 2 + (c >> 5), rr = r & 15, cc = c & 31, ob = rr * 64 + cc * 2; return st * 1024 + (ob ^ (((ob >> 9) & 1) << 5)); }
__host__ __device__ __forceinline__ void stage_rc(int b, int& R, int& C) { const int st = b / 1024, sb = b % 1024, swz = sb ^ (((sb >> 9) & 1) << 5); R = (st >> 1) * 16 + swz / 64; C = (st & 1) * 32 + (swz % 64) / 2; }
__host__ __device__ __forceinline__ int perm32(int rho) { const int n = rho >> 4, i = rho & 15; return 8 * (i >> 2) + 4 * n + (i & 3); }

struct Unit { int pm, pn; };
struct Gemm { const bf16_t* A; const bf16_t* Bt; int M, N, K; };

struct StaticOrder {
    int nM, nN, nwg, G, c;
    __host__ __device__ void init(int M, int N, int G_, int c_) { nM = M / BM; nN = N / BM; nwg = nM * nN; G = G_; c = c_; }
    __host__ __device__ bool next(int i, Unit& u) const {
        const long L = (long)i * G + c; if (L >= nwg) return false;
        int wgid = (int)L; { const int q = nwg / NXCD, r = nwg % NXCD, xcd = wgid % NXCD, off = wgid / NXCD; wgid = (xcd < r ? xcd * (q + 1) : r * (q + 1) + (xcd - r) * q) + off; }
        const int nig = WGM * nN, gid = wgid / nig, fm = gid * WGM, gsz = (nM - fm) < WGM ? (nM - fm) : WGM;
        u.pm = fm + ((wgid % nig) % gsz); u.pn = (wgid % nig) / gsz; return true;
    }
    __device__ __forceinline__ void a_ready(const Unit&) const {}
    __device__ __forceinline__ void done(const Unit&) const {}
};

__device__ __forceinline__ unsigned cvt_pk_bf16(float lo, float hi) { unsigned r; asm volatile("v_cvt_pk_bf16_f32 %0, %1, %2" : "=v"(r) : "v"(lo), "v"(hi)); return r; }
template <class Epi, class Sched, bool ALIGN_EPI = false, bool SP2 = false>
__device__ __forceinline__ void gemm_phase(PG8_LAS unsigned char* lds, const Gemm g, const Sched& S, const Epi& E, int wave_s) {
    asm volatile("" : "+s"(wave_s));
    unsigned mall = ~0u; asm volatile("" : "+s"(mall));
    int tid = wave_s * 64 + (int)__builtin_amdgcn_mbcnt_hi(mall, __builtin_amdgcn_mbcnt_lo(mall, 0u)); asm volatile("" : "+v"(tid));
    const int wid = __builtin_amdgcn_readfirstlane(tid >> 6), lane = tid & 63, wr = wid >> 2, wc = wid & 3, fr = lane & 15, fq = lane >> 4;
    const int K = g.K, nt = K / BK;
    unsigned voffA[2], voffB[2];
#pragma unroll
    for (int i = 0; i < 2; ++i) { int R, C; stage_rc(tid * 16 + i * 8192, R, C); const int Rb = Epi::PERM ? ((R & ~31) + perm32(R & 31)) : R;
        voffA[i] = (unsigned)(R * K + C) * 2u; voffB[i] = (unsigned)(Rb * K + C) * 2u; }
    const size_t kstep = (size_t)(BK * 2);
    const size_t hstep = (size_t)HALF * K * 2;
    const size_t tstep = 2 * hstep;
    const unsigned ldsw = (unsigned)wid * 1024u;
    const int aoff = lds_byte(wr * 64 + fr, fq * 8), boff = lds_byte(wc * 32 + fr, fq * 8);
#define PG8_SA(b, h) (((b) * 2 + (h)) * HTB)
#define PG8_SB(b, h) ((4 + (b) * 2 + (h)) * HTB)
#define PG8_STAGE(bufoff, gbase, voff) do { _Pragma("unroll") for (int _i = 0; _i < 2; ++_i) \
        __builtin_amdgcn_global_load_lds((const unsigned*)((const char*)(gbase) + (voff)[_i]), (PG8_LAS unsigned*)(lds + (bufoff) + ldsw + _i * 8192), 16, 0, 0); } while (0)
#define PG8_LDA(dst, b, h) do { _Pragma("unroll") for (int m = 0; m < 4; ++m) _Pragma("unroll") for (int k = 0; k < 2; ++k) dst[m][k] = *(const PG8_LAS bf16x8*)(lds + PG8_SA(b, h) + aoff + m * 2048 + k * 1024); } while (0)
#define PG8_LDB(dst, b, h) do { _Pragma("unroll") for (int n = 0; n < 2; ++n) _Pragma("unroll") for (int k = 0; k < 2; ++k) dst[n][k] = *(const PG8_LAS bf16x8*)(lds + PG8_SB(b, h) + boff + n * 2048 + k * 1024); } while (0)
#define PG8_MMA(ai, bj, At, Bt) do { __builtin_amdgcn_s_setprio(1); _Pragma("unroll") for (int m = 0; m < 4; ++m) _Pragma("unroll") for (int n = 0; n < 2; ++n) _Pragma("unroll") for (int k = 0; k < 2; ++k) \
        acc[ai][bj][m][n] = __builtin_amdgcn_mfma_f32_16x16x32_bf16(Bt[n][k], At[m][k], acc[ai][bj][m][n], 0, 0, 0); __builtin_amdgcn_s_setprio(0); } while (0)
#define PG8_WAIT_V(n) asm volatile("s_waitcnt vmcnt(" #n ")" ::: "memory")
#define PG8_WAIT_L(n) asm volatile("s_waitcnt lgkmcnt(" #n ")" ::: "memory")
#define PG8_BAR __builtin_amdgcn_s_barrier()
#define PG8_SCHED __builtin_amdgcn_sched_barrier(0)
    Unit cur, nxt; int ui = 0;
    if (!S.next(0, cur)) return;
    f32x4 acc[2][2][4][2];
#pragma unroll
    for (int a = 0; a < 2; ++a)
#pragma unroll
        for (int b = 0; b < 2; ++b)
#pragma unroll
            for (int m = 0; m < 4; ++m)
#pragma unroll
                for (int n = 0; n < 2; ++n) acc[a][b][m][n] = (f32x4){0.f, 0.f, 0.f, 0.f};
    bf16x8 At[4][2], B0[2][2], B1[2][2];
    const char* cA = (const char*)g.A + (size_t)cur.pm * tstep; const char* cB = (const char*)g.Bt + (size_t)cur.pn * tstep;
    S.a_ready(cur);
    if constexpr (SP2) {
        PG8_STAGE(PG8_SB(0, 0), cB, voffB); PG8_STAGE(PG8_SB(0, 1), cB + hstep, voffB); PG8_STAGE(PG8_SA(0, 0), cA, voffA); PG8_STAGE(PG8_SA(0, 1), cA + hstep, voffA);
        if (wr == 1) PG8_BAR;
        PG8_WAIT_V(2); PG8_BAR;
        PG8_STAGE(PG8_SB(1, 0), cB + kstep, voffB); PG8_STAGE(PG8_SA(1, 0), cA + kstep, voffA); PG8_STAGE(PG8_SB(1, 1), cB + hstep + kstep, voffB);
        PG8_WAIT_V(6); PG8_BAR;
    } else {
        PG8_STAGE(PG8_SB(0, 0), cB, voffB); PG8_STAGE(PG8_SA(0, 0), cA, voffA); PG8_STAGE(PG8_SB(0, 1), cB + hstep, voffB); PG8_STAGE(PG8_SA(0, 1), cA + hstep, voffA);
        if (wr == 1) PG8_BAR;
        PG8_WAIT_V(4); PG8_BAR;
        PG8_STAGE(PG8_SB(1, 0), cB + kstep, voffB); PG8_STAGE(PG8_SA(1, 0), cA + kstep, voffA); PG8_STAGE(PG8_SB(1, 1), cB + hstep + kstep, voffB);
        PG8_WAIT_V(6); PG8_BAR;
    }
    for (;;) {
        const bool has_next = S.next(ui + 1, nxt);
        const char* nA = has_next ? (const char*)g.A + (size_t)nxt.pm * tstep : cA; const char* nB = has_next ? (const char*)g.Bt + (size_t)nxt.pn * tstep : cB;
        for (int t = 0; t < nt; t += 2) {
            const bool last = (t == nt - 2);
            const char* a1 = cA + (size_t)(t + 1) * kstep;
            const char* a2 = last ? nA : cA + (size_t)(t + 2) * kstep; const char* b2 = last ? nB : cB + (size_t)(t + 2) * kstep;
            const char* a3 = a2 + kstep; const char* b3 = b2 + kstep;
            if (last && has_next) S.a_ready(nxt);
            if constexpr (SP2) {
            PG8_LDB(B0, 0, 0); PG8_LDB(B1, 0, 1); PG8_SCHED; PG8_LDA(At, 0, 0); PG8_STAGE(PG8_SA(1, 1), a1 + hstep, voffA);
            PG8_WAIT_V(8); PG8_WAIT_L(0); PG8_BAR; PG8_MMA(0, 0, At, B0); PG8_MMA(0, 1, At, B1); PG8_BAR; PG8_SCHED;
            PG8_LDA(At, 0, 1); PG8_STAGE(PG8_SB(0, 0), b2, voffB); PG8_STAGE(PG8_SB(0, 1), b2 + hstep, voffB); PG8_STAGE(PG8_SA(0, 0), a2, voffA);
            PG8_WAIT_V(8); PG8_WAIT_L(0); PG8_BAR; PG8_MMA(1, 0, At, B0); PG8_MMA(1, 1, At, B1); PG8_BAR; PG8_SCHED;
            PG8_LDB(B0, 1, 0); PG8_LDB(B1, 1, 1); PG8_SCHED; PG8_LDA(At, 1, 0); PG8_STAGE(PG8_SA(0, 1), a2 + hstep, voffA);
            PG8_WAIT_V(8); PG8_WAIT_L(0); PG8_BAR; PG8_MMA(0, 0, At, B0); PG8_MMA(0, 1, At, B1); PG8_BAR; PG8_SCHED;
            PG8_LDA(At, 1, 1); PG8_STAGE(PG8_SB(1, 0), b3, voffB); PG8_STAGE(PG8_SB(1, 1), b3 + hstep, voffB); PG8_STAGE(PG8_SA(1, 0), a3, voffA);
            PG8_WAIT_V(8); PG8_WAIT_L(0); PG8_BAR; PG8_MMA(1, 0, At, B0); PG8_MMA(1, 1, At, B1); PG8_BAR; PG8_SCHED;
            } else {
            PG8_LDB(B0, 0, 0); PG8_SCHED; PG8_LDA(At, 0, 0); PG8_STAGE(PG8_SA(1, 1), a1 + hstep, voffA);
            PG8_WAIT_L(8); PG8_BAR; PG8_WAIT_L(0); PG8_MMA(0, 0, At, B0); PG8_BAR; PG8_SCHED;
            PG8_LDB(B1, 0, 1); PG8_STAGE(PG8_SB(0, 0), b2, voffB);
            PG8_BAR; PG8_WAIT_L(0); PG8_MMA(0, 1, At, B1); PG8_BAR;
            PG8_LDA(At, 0, 1); PG8_STAGE(PG8_SA(0, 0), a2, voffA);
            PG8_BAR; PG8_WAIT_L(0); PG8_MMA(1, 0, At, B0); PG8_BAR; PG8_SCHED;
            PG8_STAGE(PG8_SB(0, 1), b2 + hstep, voffB);
            PG8_WAIT_V(6); PG8_BAR; PG8_MMA(1, 1, At, B1); PG8_BAR;
            PG8_LDB(B0, 1, 0); PG8_SCHED; PG8_LDA(At, 1, 0); PG8_STAGE(PG8_SA(0, 1), a2 + hstep, voffA);
            PG8_WAIT_L(8); PG8_BAR; PG8_WAIT_L(0); PG8_MMA(0, 0, At, B0); PG8_BAR; PG8_SCHED;
            PG8_LDB(B1, 1, 1); PG8_STAGE(PG8_SB(1, 0), b3, voffB);
            PG8_BAR; PG8_WAIT_L(0); PG8_MMA(0, 1, At, B1); PG8_BAR;
            PG8_LDA(At, 1, 1); PG8_STAGE(PG8_SA(1, 0), a3, voffA);
            PG8_BAR; PG8_WAIT_L(0); PG8_MMA(1, 0, At, B0); PG8_BAR; PG8_SCHED;
            PG8_STAGE(PG8_SB(1, 1), b3 + hstep, voffB);
            PG8_WAIT_V(6); PG8_BAR; PG8_MMA(1, 1, At, B1); PG8_BAR;
            }
        }
        if constexpr (ALIGN_EPI) { if (wr == 0) PG8_BAR; }
        if constexpr (!Epi::AFTER_DRAIN) { E(acc, cur, wr, wc, fr, fq); S.done(cur); }
        if (!has_next) break;
#pragma unroll
        for (int a = 0; a < 2; ++a)
#pragma unroll
            for (int b = 0; b < 2; ++b)
#pragma unroll
                for (int m = 0; m < 4; ++m)
#pragma unroll
                    for (int n = 0; n < 2; ++n) acc[a][b][m][n] = (f32x4){0.f, 0.f, 0.f, 0.f};
        cur = nxt; cA = nA; cB = nB; ++ui;
        if constexpr (ALIGN_EPI) { if (wr == 1) PG8_BAR; }
    }
    PG8_WAIT_V(0);
    if constexpr (!ALIGN_EPI) { if (wr == 0) PG8_BAR; }
    PG8_BAR;
    if constexpr (Epi::AFTER_DRAIN) { E.fused(acc, cur, wr, wc, fr, fq, lds, wid, lane); S.done(cur); }
#undef PG8_SA
#undef PG8_SB
#undef PG8_STAGE
#undef PG8_LDA
#undef PG8_LDB
#undef PG8_MMA
#undef PG8_WAIT_V
#undef PG8_WAIT_L
#undef PG8_BAR
#undef PG8_SCHED
}
}

#define LAS __attribute__((address_space(3)))
typedef unsigned short bf16;
typedef unsigned u32x4 __attribute__((ext_vector_type(4)));
typedef unsigned u32x2 __attribute__((ext_vector_type(2)));
typedef float f32x4 __attribute__((ext_vector_type(4)));
typedef float f32x16 __attribute__((ext_vector_type(16)));
typedef short bf16x8 __attribute__((ext_vector_type(8)));
typedef short v4s __attribute__((ext_vector_type(4)));
using pg8::cvt_pk_bf16;

constexpr int D = 1024, SEQ = 8192, NB = 4, NSB = 16, SL = 16, PAST = 1024, DFF = 2816;
constexpr int R_ALL = 33280, R_TAIL = 33024, ROW_S0 = 32768, ROW_M0 = 33024;
constexpr int KROWS = 8208;
constexpr float LOG2E = 1.4426950408889634f;
constexpr float QSCALE = 0.125f * 1.4426950408889634f;
constexpr size_t O_YP = 0, O_YS = 33554432, O_KP = 33816576, O_VP = 67436544, O_SP = 101056512, O_KS = 101580800, O_VS = 101842944, O_SS = 102105088;
constexpr size_t MiB = 1u << 20;
constexpr size_t WS_CTL = 0, CTL_BYTES = 65536;
constexpr size_t WS_WIN = 1 * MiB, WS_WRB = 17 * MiB, WS_WDB = 19 * MiB, WS_WO = 21 * MiB, WS_WUP = 23 * MiB, WS_WDN = 34 * MiB;
constexpr size_t WS_CS = 40 * MiB, WS_SS1 = 45 * MiB, WS_SS2 = 48 * MiB;
constexpr size_t WS_XN = 52 * MiB, WS_QR = 117 * MiB, WS_KR = WS_QR + (size_t)R_ALL * 512 * 2, WS_VR = 182 * MiB, WS_DQ = 247 * MiB;
constexpr size_t WS_DK = 312 * MiB, WS_DV = 377 * MiB, WS_RG = 442 * MiB, WS_END = 507 * MiB;
constexpr size_t WS_H1B = WS_XN, WS_MG = WS_DV, WS_HID = WS_QR, WS_YD = WS_DQ, WS_LS = WS_XN, WS_H2B = WS_MG;
constexpr int CW_QUEUE = 8192, CW_XQ = 8448;
constexpr int LDS_BYTES = 147456;
constexpr int LDS_MISC = 143360;

struct Ctx {
    const float *x_prompt, *x_sample, *cache_k, *cache_v, *state_ret, *meta, *rel_bias, *n1g, *w_in, *lq1, *lk1, *lq2, *lk2, *subg,
                *w_rb, *w_db, *w_o, *n2g, *w_up, *w_down, *nfg;
    float* out; unsigned char* ws;
};

__device__ __forceinline__ float wave_sum(float v) {
#pragma unroll
    for (int o = 1; o < 64; o <<= 1) v += __shfl_xor(v, o);
    return v;
}
__device__ __forceinline__ unsigned f2bf(float f) { unsigned u = __builtin_bit_cast(unsigned, f); return (u + 0x7fffu + ((u >> 16) & 1u)) >> 16; }
__device__ __forceinline__ float bf2f(unsigned short b) { return __builtin_bit_cast(float, (unsigned)b << 16); }
__device__ __forceinline__ float sigm_f(float x) { return __builtin_amdgcn_rcpf(1.f + __builtin_amdgcn_exp2f(-1.4426950408889634f * x)); }
__device__ __forceinline__ float silu_f(float x) { return x * sigm_f(x); }
__device__ __forceinline__ int fresh_tid(int wave_s) { unsigned m = ~0u; asm volatile("" : "+s"(m)); int t = wave_s * 64 + (int)__builtin_amdgcn_mbcnt_hi(m, __builtin_amdgcn_mbcnt_lo(m, 0u)); asm volatile("" : "+v"(t)); return t; }
__device__ __forceinline__ u32x4 pack8(const f32x4& a, const f32x4& b) {
    u32x4 w; w.x = cvt_pk_bf16(a[0], a[1]); w.y = cvt_pk_bf16(a[2], a[3]); w.z = cvt_pk_bf16(b[0], b[1]); w.w = cvt_pk_bf16(b[2], b[3]); return w;
}
__device__ __forceinline__ void unpack8(const u32x4& w, float* f) {
    f[0] = __builtin_bit_cast(float, w.x << 16); f[1] = __builtin_bit_cast(float, w.x & 0xffff0000u);
    f[2] = __builtin_bit_cast(float, w.y << 16); f[3] = __builtin_bit_cast(float, w.y & 0xffff0000u);
    f[4] = __builtin_bit_cast(float, w.z << 16); f[5] = __builtin_bit_cast(float, w.z & 0xffff0000u);
    f[6] = __builtin_bit_cast(float, w.w << 16); f[7] = __builtin_bit_cast(float, w.w & 0xffff0000u);
}
__device__ __forceinline__ int crow(int r, int hi) { return (r & 3) + 8 * (r >> 2) + 4 * hi; }
__device__ __forceinline__ v4s tr16(LAS const unsigned char* p) { return __builtin_amdgcn_ds_read_tr16_b64_v4i16((LAS v4s*)p); }
#define MFMA32(a, b, c) __builtin_amdgcn_mfma_f32_32x32x16_bf16((a), (b), (c), 0, 0, 0)
__device__ __forceinline__ bf16x8 cat4(v4s lo, v4s hi) { return __builtin_shufflevector(lo, hi, 0, 1, 2, 3, 4, 5, 6, 7); }
__device__ __forceinline__ bf16x8 pack_step(const f32x16& x, int s) {
    u32x4 p; p.x = cvt_pk_bf16(x[8 * s], x[8 * s + 1]); p.y = cvt_pk_bf16(x[8 * s + 2], x[8 * s + 3]); p.z = cvt_pk_bf16(x[8 * s + 4], x[8 * s + 5]); p.w = cvt_pk_bf16(x[8 * s + 6], x[8 * s + 7]);
    return __builtin_bit_cast(bf16x8, p);
}

#define XB_TMO      128
#define XB_XCNT(j)  (256  + 64 * (j))
#define XB_XSUB(j)  (1280 + 64 * (j))
#define XB_XGEN(j)  (2304 + 64 * (j))
#define XB_TOP      3328
#define XB_TOPGEN   3392
#define XCD_BAR_WORDS 3456
#define XB_SPIN_CAP (1u << 22)
__device__ __forceinline__ unsigned xb_ld(unsigned* p)              { return __hip_atomic_load(p, __ATOMIC_RELAXED, __HIP_MEMORY_SCOPE_AGENT); }
__device__ __forceinline__ unsigned xb_add(unsigned* p, unsigned v) { return __hip_atomic_fetch_add(p, v, __ATOMIC_RELAXED, __HIP_MEMORY_SCOPE_AGENT); }
__device__ __forceinline__ unsigned xb_xcc_id() { return (unsigned)__builtin_amdgcn_s_getreg((3 << 11) | 20) & 0xFu; }
#define XB_SPIN(cond, bar) do { unsigned _sp = 0; while (cond) { __builtin_amdgcn_s_sleep(1); \
    if ((++_sp & 255u) == 0u) { if (xb_ld(&(bar)[XB_TMO])) break; if (_sp > XB_SPIN_CAP) { atomicAdd(&(bar)[XB_TMO], 1u); break; } } } } while (0)
struct XcdBarrier { unsigned* bar; unsigned x; volatile LAS unsigned* st; int wave_s; };
__device__ __forceinline__ XcdBarrier xcd_barrier_post(unsigned* bar, volatile LAS unsigned* st, int wave_s) {
    XcdBarrier b; b.bar = bar; b.x = xb_xcc_id(); b.st = st; b.wave_s = wave_s;
    if (fresh_tid(wave_s) == 0) (void)xb_add(&bar[XB_XCNT(b.x)], 1u);
    return b;
}
__device__ __forceinline__ void xcd_barrier_complete(unsigned* bar, unsigned x, unsigned& nloc, unsigned& nx) {
    const unsigned G = gridDim.x * gridDim.y * gridDim.z;
    unsigned sum, cnt, mine, sp = 0u;
    for (;;) {
        sum = 0u; cnt = 0u; mine = 0u;
#pragma unroll
        for (unsigned j = 0; j < 16; ++j) { const unsigned c = xb_ld(&bar[XB_XCNT(j)]); sum += c; cnt += (c > 0u) ? 1u : 0u; mine = (j == x) ? c : mine; }
        if (sum == G) break;
        __builtin_amdgcn_s_sleep(1);
        if ((++sp & 255u) == 0u) { if (xb_ld(&bar[XB_TMO])) break; if (sp > XB_SPIN_CAP) { atomicAdd(&bar[XB_TMO], 1u); break; } }
    }
    nloc = mine > 0u ? mine : 1u; nx = cnt > 0u ? cnt : 1u;
}
__device__ __forceinline__ void xcd_barrier(const XcdBarrier& b) {
    asm volatile("s_waitcnt vmcnt(0)" ::: "memory");
    __syncthreads();
    if (fresh_tid(b.wave_s) == 0) {
        unsigned* bar = b.bar;
        __builtin_amdgcn_s_waitcnt(0);
        unsigned nloc = b.st[0], nx = b.st[1];
        if (nloc == 0u) { xcd_barrier_complete(bar, b.x, nloc, nx); b.st[0] = nloc; b.st[1] = nx; }
        const unsigned old = xb_add(&bar[XB_XSUB(b.x)], 1u);
        const unsigned gen = old / nloc;
        if (old + 1u == (gen + 1u) * nloc) {
            __builtin_amdgcn_fence(__ATOMIC_RELEASE, "agent");
            asm volatile("s_waitcnt vmcnt(0)" ::: "memory");
            const unsigned og = xb_add(&bar[XB_TOP], 1u);
            const unsigned tg = og / nx;
            if (og + 1u == (tg + 1u) * nx) xb_add(&bar[XB_TOPGEN], 1u);
            else XB_SPIN(xb_ld(&bar[XB_TOPGEN]) == tg, bar);
            __builtin_amdgcn_fence(__ATOMIC_ACQUIRE, "agent");
            xb_add(&bar[XB_XGEN(b.x)], 1u);
            asm volatile("s_waitcnt vmcnt(0)" ::: "memory");
        } else {
            XB_SPIN(xb_ld(&bar[XB_XGEN(b.x)]) == gen, bar);
            __builtin_amdgcn_fence(__ATOMIC_ACQUIRE, "agent");
            asm volatile("s_waitcnt vmcnt(0)" ::: "memory");
        }
    }
    __syncthreads();
}

__device__ __forceinline__ int win_src(int n) {
    if (n >= 1024) return n;
    const int hh = n >> 7, p = n & 127, dd = 4 * (p >> 3) + (p & 3), half = (p >> 2) & 1;
    return hh * 128 + 64 * half + dd;
}
__device__ __forceinline__ int wup_src(int n) { const int pn = n >> 8, lc = n & 255; return (lc >> 7) * DFF + 128 * pn + (lc & 127); }
template <int MODE> __device__ __forceinline__ void transpose_item(const float* W, int K, int N, bf16* WT, LAS float* scr, int item, int lane, const float* kscale) {
    const int nblk = N / 32, kb = item / nblk, nb = item % nblk, k0 = 64 * kb, n0 = 32 * nb;
    const int l8 = lane & 7, kr = lane >> 3;
    const int nn = n0 + 4 * l8; const int src = MODE == 1 ? win_src(nn) : (MODE == 2 ? wup_src(nn) : nn);
#pragma unroll
    for (int i = 0; i < 8; ++i) { const int kk = 8 * i + kr; f32x4 v = __builtin_nontemporal_load((const f32x4*)(W + (size_t)(k0 + kk) * N + src)); if (MODE == 2) v = v * kscale[k0 + kk];
        LAS float* d = scr + kk * 33 + 4 * l8; d[0] = v[0]; d[1] = v[1]; d[2] = v[2]; d[3] = v[3]; }
    asm volatile("s_waitcnt lgkmcnt(0)" ::: "memory");
    const int c = lane & 7;
#pragma unroll
    for (int j = 0; j < 4; ++j) { const int n = (lane >> 3) + 8 * j; const LAS float* s = scr + (8 * c) * 33 + n;
        u32x4 o; o.x = cvt_pk_bf16(s[0 * 33], s[1 * 33]); o.y = cvt_pk_bf16(s[2 * 33], s[3 * 33]); o.z = cvt_pk_bf16(s[4 * 33], s[5 * 33]); o.w = cvt_pk_bf16(s[6 * 33], s[7 * 33]);
        *(u32x4*)(WT + (size_t)(n0 + n) * K + k0 + 8 * c) = o; }
    asm volatile("s_waitcnt lgkmcnt(0)" ::: "memory");
}
__device__ __forceinline__ void p0_prep(const Ctx& c, LAS unsigned char* lds, int vcu, int G, int wave_s) {
    const int tid_ = fresh_tid(wave_s); const int lane = tid_ & 63, wave = __builtin_amdgcn_readfirstlane(tid_ >> 6);
    unsigned char* ws = c.ws;
    LAS float* scr = (LAS float*)(lds + wave * 16384);
    const int gw = vcu * 8 + wave, NGW = G * 8;
    constexpr int I_IN = (D / 64) * (8192 / 32), I_SQ = (D / 64) * (D / 32), I_UP = (D / 64) * (2 * DFF / 32), I_DN = (DFF / 64) * (D / 32);
    constexpr int NITEMS = I_IN + 3 * I_SQ + I_UP + I_DN;
    for (int it = gw; it < NITEMS; it += NGW) {
        int r = it;
        if (r < I_IN) { transpose_item<1>(c.w_in, D, 8192, (bf16*)(ws + WS_WIN), scr, r, lane, nullptr); continue; } r -= I_IN;
        if (r < I_SQ) { transpose_item<0>(c.w_rb, D, D, (bf16*)(ws + WS_WRB), scr, r, lane, nullptr); continue; } r -= I_SQ;
        if (r < I_SQ) { transpose_item<0>(c.w_db, D, D, (bf16*)(ws + WS_WDB), scr, r, lane, nullptr); continue; } r -= I_SQ;
        if (r < I_SQ) { transpose_item<0>(c.w_o, D, D, (bf16*)(ws + WS_WO), scr, r, lane, nullptr); continue; } r -= I_SQ;
        if (r < I_UP) { transpose_item<2>(c.w_up, D, 2 * DFF, (bf16*)(ws + WS_WUP), scr, r, lane, c.n2g); continue; } r -= I_UP;
        transpose_item<0>(c.w_down, DFF, D, (bf16*)(ws + WS_WDN), scr, r, lane, nullptr);
    }
    bf16* XN = (bf16*)(ws + WS_XN);
    for (int m = gw; m < R_ALL; m += NGW) {
        unsigned long long* o8 = (unsigned long long*)(XN + (size_t)m * D) + lane;
        if (m >= ROW_M0 + 16) {
#pragma unroll
            for (int j = 0; j < 4; ++j) o8[64 * j] = 0ull;
            continue; }
        const float* src = m < ROW_S0 ? c.x_prompt + (size_t)m * D : (m < ROW_M0 ? c.x_sample + (size_t)(m - ROW_S0) * D : c.meta + (size_t)(m - ROW_M0) * D);
        const f32x4* xr = (const f32x4*)src + lane; const f32x4* gr = (const f32x4*)c.n1g + lane;
        f32x4 v[4]; float s = 0.f;
#pragma unroll
        for (int j = 0; j < 4; ++j) { v[j] = __builtin_nontemporal_load(xr + 64 * j); s += (v[j].x * v[j].x + v[j].y * v[j].y) + (v[j].z * v[j].z + v[j].w * v[j].w); }
        const float rstd = 1.f / sqrtf(wave_sum(s) * (1.f / D) + 1e-6f);
#pragma unroll
        for (int j = 0; j < 4; ++j) { const f32x4 g = gr[64 * j]; const f32x4 y = v[j] * rstd * g;
            o8[64 * j] = (unsigned long long)cvt_pk_bf16(y.x, y.y) | ((unsigned long long)cvt_pk_bf16(y.z, y.w) << 32); }
    }
    float2* CS = (float2*)(ws + WS_CS);
    const int gt = vcu * 512 + tid_, NGT = G * 512;
    for (int e = gt; e < KROWS * 64; e += NGT) {
        const int d = e & 63, pos = (e >> 6) - 16;
        const double fr = exp2(-(double)d * (13.287712379549449 / 63.0));
        const double rev = (double)pos * fr * 0.15915494309189535;
        const float fx = (float)(rev - rint(rev));
        CS[e] = make_float2(__builtin_amdgcn_cosf(fx), __builtin_amdgcn_sinf(fx));
    }
}

using pg8::Unit;
__device__ __forceinline__ int pos_index(int row) { return row < ROW_S0 ? (row & 8191) + 16 : (row < ROW_M0 ? 1040 + (row & 15) : (row < ROW_M0 + 16 ? row - ROW_M0 : 0)); }

struct EpiIn {
    static constexpr bool PERM = true, AFTER_DRAIN = false;
    Ctx c;
    __device__ __forceinline__ void operator()(const pg8::f32x4 (&acc)[2][2][4][2], const Unit& u, int wr, int wc, int fr, int fq) const {
        const int pn = u.pn, rbase = u.pm * 256 + wr * 64 + fr, cl = wc * 32 + 8 * fq;
        unsigned char* ws = c.ws;
        if (pn < 4) {
            const bool isq = pn < 2; bf16* dst = (bf16*)(ws + (isq ? WS_QR : WS_KR));
            const float sc = isq ? 0.08838834764831845f : 1.f; const int dd = 16 * wc + 4 * fq;
            const float2* CS = (const float2*)(ws + WS_CS);
#pragma unroll
            for (int ai = 0; ai < 2; ++ai)
#pragma unroll
                for (int m = 0; m < 4; ++m) { const int row = rbase + ai * 128 + m * 16; const f32x4* cs = (const f32x4*)(CS + (size_t)pos_index(row) * 64 + dd);
                    const f32x4 cs0 = cs[0], cs1 = cs[1];
                    const float cc[4] = {cs0[0], cs0[2], cs1[0], cs1[2]}, ss[4] = {cs0[1], cs0[3], cs1[1], cs1[3]};
#pragma unroll
                    for (int bj = 0; bj < 2; ++bj) { const f32x4 x1 = acc[ai][bj][m][0], x2 = acc[ai][bj][m][1]; float o1[4], o2[4];
#pragma unroll
                        for (int j = 0; j < 4; ++j) { o1[j] = (x1[j] * cc[j] - x2[j] * ss[j]) * sc; o2[j] = (x1[j] * ss[j] + x2[j] * cc[j]) * sc; }
                        bf16* p = dst + (size_t)row * 512 + ((pn & 1) * 2 + bj) * 128 + dd;
                        u32x2 w1, w2; w1.x = cvt_pk_bf16(o1[0], o1[1]); w1.y = cvt_pk_bf16(o1[2], o1[3]); w2.x = cvt_pk_bf16(o2[0], o2[1]); w2.y = cvt_pk_bf16(o2[2], o2[3]);
                        *(u32x2*)p = w1; *(u32x2*)(p + 64) = w2; } }
            return;
        }
        const int grp = pn >> 2, ct = (pn & 3) * 256;
#pragma unroll
        for (int ai = 0; ai < 2; ++ai)
#pragma unroll
            for (int m = 0; m < 4; ++m) { const int row = rbase + ai * 128 + m * 16;
#pragma unroll
                for (int bj = 0; bj < 2; ++bj) { const int col = ct + bj * 128 + cl; f32x4 v0 = acc[ai][bj][m][0], v1 = acc[ai][bj][m][1];
                    if (grp == 1) { *(u32x4*)((bf16*)(ws + WS_VR) + (size_t)row * D + col) = pack8(v0, v1); }
                    else if (grp == 2) { __builtin_nontemporal_store(pack8(v0, v1), (u32x4*)((bf16*)(ws + WS_RG) + (size_t)row * D + col)); }
                    else if (grp == 3) { v0 = v0 * QSCALE; v1 = v1 * QSCALE; __builtin_nontemporal_store(pack8(v0, v1), (u32x4*)((bf16*)(ws + WS_DQ) + (size_t)row * D + col)); }
                    else if (grp == 4 || grp == 5) {
                        bf16* bb = (bf16*)(ws + (grp == 4 ? WS_DK : WS_DV)); float* fp = c.out + (grp == 4 ? O_KP : O_VP); float* fs = c.out + (grp == 4 ? O_KS : O_VS);
                        const u32x4 w = pack8(v0, v1);
                        const int hh = col >> 7, hc = col & 127;
                        if (row < ROW_S0) { const size_t rr = (size_t)(row >> 13) * KROWS + 16 + (row & 8191); const size_t hb = ((size_t)((row >> 13) * 8 + hh) * KROWS + 16 + (row & 8191)) * 128 + hc;
                            *(u32x4*)(bb + hb) = w; __builtin_nontemporal_store(v0, (f32x4*)(fp + rr * D + col)); __builtin_nontemporal_store(v1, (f32x4*)(fp + rr * D + col + 4)); }
                        else if (row < ROW_M0) { const size_t rr = (size_t)(row - ROW_S0); *(f32x4*)(fs + rr * D + col) = v0; *(f32x4*)(fs + rr * D + col + 4) = v1; }
                        else if (row < ROW_M0 + 16) {
#pragma unroll
                            for (int b = 0; b < NB; ++b) { const size_t rr = (size_t)b * KROWS + (row - ROW_M0); const size_t hb = ((size_t)(b * 8 + hh) * KROWS + (row - ROW_M0)) * 128 + hc;
                                *(u32x4*)(bb + hb) = w; *(f32x4*)(fp + rr * D + col) = v0; *(f32x4*)(fp + rr * D + col + 4) = v1; } }
                    } else {
                        if (row < ROW_M0) {
#pragma unroll
                            for (int j = 0; j < 4; ++j) { v0[j] = sigm_f(v0[j]); v1[j] = sigm_f(v1[j]); }
                            bf16* g = row < ROW_S0 ? (bf16*)(c.out + O_YP) + (size_t)(grp - 6) * ROW_S0 * D + (size_t)row * D
                                                   : (bf16*)(c.out + O_YS) + (size_t)(grp - 6) * 256 * D + (size_t)(row - ROW_S0) * D;
                            __builtin_nontemporal_store(pack8(v0, v1), (u32x4*)(g + col)); } }
                } }
    }
};
__device__ __forceinline__ const bf16* gate_row(const Ctx& c, int which, int row) {
    return row < ROW_S0 ? (const bf16*)(c.out + O_YP) + (size_t)which * ROW_S0 * D + (size_t)row * D : (const bf16*)(c.out + O_YS) + (size_t)which * 256 * D + (size_t)(row - ROW_S0) * D;
}
template <int WHICH> struct EpiBranch {
    static constexpr bool PERM = true, AFTER_DRAIN = false;
    Ctx c;
    __device__ __forceinline__ void operator()(const pg8::f32x4 (&acc)[2][2][4][2], const Unit& u, int wr, int wc, int fr, int fq) const {
        const int rbase = u.pm * 256 + wr * 64 + fr, cl = u.pn * 256 + wc * 32 + 8 * fq; bf16* MG = (bf16*)(c.ws + WS_MG);
#pragma unroll
        for (int ai = 0; ai < 2; ++ai)
#pragma unroll
            for (int m = 0; m < 4; ++m) { const int row = rbase + ai * 128 + m * 16; const bf16* g = gate_row(c, WHICH, row);
#pragma unroll
                for (int bj = 0; bj < 2; ++bj) { const int col = cl + bj * 128; float gf[8]; unpack8(__builtin_nontemporal_load((const u32x4*)(g + col)), gf);
                    f32x4 v0 = acc[ai][bj][m][0], v1 = acc[ai][bj][m][1];
                    if (WHICH == 1) { float tf[8]; unpack8(*(const u32x4*)(MG + (size_t)row * D + col), tf);
#pragma unroll
                        for (int j = 0; j < 4; ++j) { v0[j] = tf[j] + gf[j] * v0[j]; v1[j] = tf[4 + j] + gf[4 + j] * v1[j]; } }
                    else {
#pragma unroll
                        for (int j = 0; j < 4; ++j) { v0[j] = gf[j] * v0[j]; v1[j] = gf[4 + j] * v1[j]; } }
                    *(u32x4*)(MG + (size_t)row * D + col) = pack8(v0, v1); } }
    }
};
__device__ __forceinline__ float* yrow(const Ctx& c, int row) { return row < ROW_S0 ? c.out + O_YP + (size_t)row * D : c.out + O_YS + (size_t)(row - ROW_S0) * D; }
template <int WHICH> struct EpiResid {
    static constexpr bool PERM = true, AFTER_DRAIN = false;
    Ctx c;
    __device__ __forceinline__ void operator()(const pg8::f32x4 (&acc)[2][2][4][2], const Unit& u, int wr, int wc, int fr, int fq) const {
        const int rbase = u.pm * 256 + wr * 64 + fr, cl = u.pn * 256 + wc * 32 + 8 * fq; bf16* HB = (bf16*)(c.ws + WS_H1B); bf16* H2 = (bf16*)(c.ws + WS_H2B);
        float* SS = (float*)(c.ws + (WHICH == 0 ? WS_SS1 : WS_SS2));
#pragma unroll
        for (int ai = 0; ai < 2; ++ai)
#pragma unroll
            for (int m = 0; m < 4; ++m) { const int row = rbase + ai * 128 + m * 16;
                const float* xin = row < ROW_S0 ? c.x_prompt + (size_t)row * D : c.x_sample + (size_t)(row - ROW_S0) * D;
                float s = 0.f;
#pragma unroll
                for (int bj = 0; bj < 2; ++bj) { const int col = cl + bj * 128; f32x4 v0, v1;
                    if (WHICH == 0) { v0 = acc[ai][bj][m][0] + __builtin_nontemporal_load((const f32x4*)(xin + col)); v1 = acc[ai][bj][m][1] + __builtin_nontemporal_load((const f32x4*)(xin + col + 4));
                        *(u32x4*)(HB + (size_t)row * D + col) = pack8(v0, v1); }
                    else { float hf[8]; unpack8(*(const u32x4*)(HB + (size_t)row * D + col), hf);
#pragma unroll
                        for (int j = 0; j < 4; ++j) { v0[j] = acc[ai][bj][m][0][j] + hf[j]; v1[j] = acc[ai][bj][m][1][j] + hf[4 + j]; }
                        *(u32x4*)(H2 + (size_t)row * D + col) = pack8(v0, v1); }
                    s += (v0[0] * v0[0] + v0[1] * v0[1]) + (v0[2] * v0[2] + v0[3] * v0[3]) + (v1[0] * v1[0] + v1[1] * v1[1]) + (v1[2] * v1[2] + v1[3] * v1[3]); }
                s += __shfl_xor(s, 16); s += __shfl_xor(s, 32);
                if (fq == 0) SS[(size_t)row * 16 + u.pn * 4 + wc] = s; }
    }
};
struct EpiUp {
    static constexpr bool PERM = true, AFTER_DRAIN = false;
    Ctx c;
    __device__ __forceinline__ void operator()(const pg8::f32x4 (&acc)[2][2][4][2], const Unit& u, int wr, int wc, int fr, int fq) const {
        const int rbase = u.pm * 256 + wr * 64 + fr, col = u.pn * 128 + wc * 32 + 8 * fq; bf16* HID = (bf16*)(c.ws + WS_HID); const float* SS = (const float*)(c.ws + WS_SS1);
#pragma unroll
        for (int ai = 0; ai < 2; ++ai)
#pragma unroll
            for (int m = 0; m < 4; ++m) { const int row = rbase + ai * 128 + m * 16; const f32x4* sp = (const f32x4*)(SS + (size_t)row * 16);
                const f32x4 a = sp[0], b = sp[1], cc = sp[2], dd = sp[3];
                const float tot = ((a[0] + a[1]) + (a[2] + a[3])) + ((b[0] + b[1]) + (b[2] + b[3])) + ((cc[0] + cc[1]) + (cc[2] + cc[3])) + ((dd[0] + dd[1]) + (dd[2] + dd[3]));
                const float rstd = 1.f / sqrtf(tot * (1.f / D) + 1e-6f);
                f32x4 h0, h1;
#pragma unroll
                for (int j = 0; j < 4; ++j) { h0[j] = silu_f(acc[ai][0][m][0][j] * rstd) * (acc[ai][1][m][0][j] * rstd); h1[j] = silu_f(acc[ai][0][m][1][j] * rstd) * (acc[ai][1][m][1][j] * rstd); }
                *(u32x4*)(HID + (size_t)row * DFF + col) = pack8(h0, h1); }
    }
};


template <int NB, class F> __device__ __forceinline__ void small_gemm(const bf16* A, int K, const bf16* const (&Bs)[NB], int rg, int wave_s, LAS unsigned char* lds, const F& epi) {
    const int tid = fresh_tid(wave_s), lane = tid & 63, w = wave_s, r32 = lane & 31, hi = lane >> 5;
    const int kw = K >> 3, steps = kw >> 4;
    const bf16* ap = A + (size_t)(ROW_S0 + 32 * rg + r32) * K + w * kw + 8 * hi;
    const bf16* bp[NB];
#pragma unroll
    for (int nb = 0; nb < NB; ++nb) bp[nb] = Bs[nb] + (size_t)r32 * K + w * kw + 8 * hi;
    f32x16 acc[NB];
#pragma unroll
    for (int nb = 0; nb < NB; ++nb)
#pragma unroll
        for (int i = 0; i < 16; ++i) acc[nb][i] = 0.f;
    for (int s0 = 0; s0 < steps; s0 += 8) {
        bf16x8 af[8], bfr[NB][8];
#pragma unroll
        for (int s = 0; s < 8; ++s) if (s0 + s < steps) { af[s] = *(const bf16x8*)(ap + 16 * (s0 + s));
#pragma unroll
            for (int nb = 0; nb < NB; ++nb) bfr[nb][s] = *(const bf16x8*)(bp[nb] + 16 * (s0 + s)); }
#pragma unroll
        for (int s = 0; s < 8; ++s) if (s0 + s < steps) {
#pragma unroll
            for (int nb = 0; nb < NB; ++nb) acc[nb] = MFMA32(af[s], bfr[nb][s], acc[nb]); }
    }
    LAS float* P = (LAS float*)lds;
#pragma unroll
    for (int nb = 0; nb < NB; ++nb)
#pragma unroll
        for (int i = 0; i < 16; ++i) P[((w * NB + nb) * 16 + i) * 64 + lane] = acc[nb][i];
    __syncthreads();
    float v[NB][2];
#pragma unroll
    for (int nb = 0; nb < NB; ++nb)
#pragma unroll
        for (int ii = 0; ii < 2; ++ii) { float t = 0.f;
#pragma unroll
            for (int ww = 0; ww < 8; ++ww) t += P[((ww * NB + nb) * 16 + 2 * w + ii) * 64 + lane];
            v[nb][ii] = t; }
    epi(v, w, r32, hi);
    __syncthreads();
}

constexpr int A_RSK = 272, A_RSV = 320, A_KSZ = 64 * A_RSK, A_VSZ = 64 * A_RSV, A_STG = A_KSZ + A_VSZ, A_Q = 2 * A_STG, A_BT = A_Q + 8 * 4096, A_END = A_BT + 1024;
__device__ __forceinline__ int t5_bucket(int rel) {
    const int n = rel < 0 ? -rel : rel; int b = rel > 0 ? 16 : 0;
    b += n < 8 ? n : (n < 12 ? 8 : (n < 16 ? 9 : (n < 23 ? 10 : (n < 32 ? 11 : (n < 46 ? 12 : (n < 64 ? 13 : (n < 91 ? 14 : 15)))))));
    return b;
}
template <bool SAMPLE, bool STORE = true> __device__ __forceinline__ void attn_unit(const Ctx& c, LAS unsigned char* lds, int b, int h, int qb, int wave_s) {
    const int tid = fresh_tid(wave_s);
    const int lane = tid & 63, wid = __builtin_amdgcn_readfirstlane(tid >> 6), r32 = lane & 31, hi = lane >> 5;
    const int g = ((wid >> 1) + 2) & 3, mp = wid & 1;
    const bool active = SAMPLE ? (g == 0) : true;
    unsigned char* ws = c.ws;
    LAS float* BT = (LAS float*)(lds + A_BT);
    if (tid < 256) { const int rel = tid - 128; BT[tid] = (c.rel_bias[t5_bucket(rel) * 8 + h] - c.rel_bias[15 * 8 + h]) * LOG2E; }
    const int tq0 = SAMPLE ? PAST : 128 * qb + 32 * g;
    const int tq = SAMPLE ? PAST + (r32 & 15) : tq0 + r32;
    const int ntiles = SAMPLE ? 17 : 2 * qb + 3;
    const int ntw = SAMPLE ? 17 : (tq0 >> 6) + 2;
    const size_t qrow = SAMPLE ? (size_t)ROW_S0 + b * 16 + (r32 & 15) : (size_t)b * SEQ + tq;
    bf16x8 qr[4];
    { const bf16* Q = (const bf16*)(ws + WS_DQ) + qrow * D + h * 128 + mp * 64 + hi * 8;
#pragma unroll
      for (int d0 = 0; d0 < 4; ++d0) qr[d0] = *(const bf16x8*)(Q + d0 * 16); }
    const int lrow = tid >> 3, lck = tid & 7;
    u32x4 kreg[2], vreg[2];
    auto load_kv = [&](int j, bool isk) {
        u32x4 r0, r1;
        if (!SAMPLE) {
            const int kidx0 = !STORE ? 64 * (j & 1) : (j == 0 ? 0 : 16 + 64 * (j - 1));
            const size_t rr = (size_t)(b * 8 + h) * KROWS + kidx0 + lrow;
            const bf16* p = (const bf16*)(ws + (isk ? WS_DK : WS_DV)) + rr * 128;
            r0 = *(const u32x4*)(p + lck * 8); r1 = *(const u32x4*)(p + 64 + lck * 8);
        } else {
            const float* p; bool ok = true;
            if (j < 16) { const size_t rr = ((size_t)b * PAST + 64 * j + lrow) * 8 + h; p = (isk ? c.cache_k : c.cache_v) + rr * 128; }
            else { ok = lrow < 16; const size_t rr = ((size_t)b * 16 + (lrow & 15)) * 8 + h; p = c.out + (isk ? O_KS : O_VS) + rr * 128; }
            r0 = pack8(*(const f32x4*)(p + lck * 8), *(const f32x4*)(p + lck * 8 + 4)); r1 = pack8(*(const f32x4*)(p + 64 + lck * 8), *(const f32x4*)(p + 64 + lck * 8 + 4));
            if (!ok) { r0 = (u32x4){0u, 0u, 0u, 0u}; r1 = r0; }
        }
        if (isk) { kreg[0] = r0; kreg[1] = r1; } else { vreg[0] = r0; vreg[1] = r1; }
    };
    auto store_k = [&](int slot) { LAS unsigned char* kb = lds + slot * A_STG + lrow * A_RSK + lck * 16; *(LAS u32x4*)kb = kreg[0]; *(LAS u32x4*)(kb + 128) = kreg[1]; };
    auto store_v = [&](int slot) { LAS unsigned char* vb = lds + slot * A_STG + A_KSZ + lrow * A_RSV + lck * 16; *(LAS u32x4*)vb = vreg[0]; *(LAS u32x4*)(vb + 128) = vreg[1]; };
    f32x16 o[4], zero16;
#pragma unroll
    for (int i = 0; i < 16; ++i) { zero16[i] = 0.f;
#pragma unroll
        for (int e = 0; e < 4; ++e) o[e][i] = 0.f; }
    float lsum = 0.f, mhat = 0.f;
    const int i16 = lane & 15, tq_ = i16 >> 2, tp_ = i16 & 3, blk = (lane >> 4) & 1;
    f32x16 p0, p1; bf16x8 pfa[4], pfb[4];
#define SB() __builtin_amdgcn_sched_barrier(0)
#define QK_TILE(ks_) do { LAS const unsigned char* kb_ = lds + (ks_) * A_STG + mp * 128 + hi * 16 + r32 * A_RSK; \
        bf16x8 kf_[8]; \
        SB(); \
        _Pragma("unroll") for (int d0 = 0; d0 < 4; ++d0) { kf_[2 * d0] = *(LAS const bf16x8*)(kb_ + d0 * 32); kf_[2 * d0 + 1] = *(LAS const bf16x8*)(kb_ + 32 * A_RSK + d0 * 32); } \
        SB(); \
        p0 = MFMA32(kf_[0], qr[0], zero16); p1 = MFMA32(kf_[1], qr[0], zero16); \
        _Pragma("unroll") for (int d0 = 1; d0 < 4; ++d0) { p0 = MFMA32(kf_[2 * d0], qr[d0], p0); p1 = MFMA32(kf_[2 * d0 + 1], qr[d0], p1); } \
        SB(); \
        if (__any(mhat != 0.f)) { _Pragma("unroll") for (int i = 0; i < 16; ++i) { p0[i] -= mhat; p1[i] -= mhat; } } } while (0)
#define ATT_MAX(j) do { \
        const int kpos0 = SAMPLE ? 64 * (j) : ((j) == 0 ? -16 : 64 * ((j) - 1)); \
        const bool partial = SAMPLE ? ((j) == 16) : ((j) == 0); \
        if (kpos0 + 63 - tq0 > -91 - 31 || partial) { \
            const int base = kpos0 - tq + 128 + 4 * hi; \
            _Pragma("unroll") for (int i = 0; i < 16; ++i) { const int kk = (i & 3) + 8 * (i >> 2); \
                int i0 = base + kk, i1 = base + kk + 32; i0 = i0 < 0 ? 0 : (i0 > 255 ? 255 : i0); i1 = i1 < 0 ? 0 : (i1 > 255 ? 255 : i1); \
                p0[i] += BT[i0]; p1[i] += BT[i1]; } } \
        if (partial) { _Pragma("unroll") for (int i = 0; i < 16; ++i) { if (crow(i, hi) >= 16) p0[i] = -INFINITY; p1[i] = -INFINITY; } } \
        float rm = fmaxf(fmaxf(p0[0], p0[1]), p1[0]), rm2 = fmaxf(fmaxf(p0[2], p0[3]), p1[1]); \
        _Pragma("unroll") for (int i = 4; i < 16; i += 4) { rm = fmaxf(fmaxf(rm, p0[i]), p0[i + 1]); rm2 = fmaxf(fmaxf(rm2, p0[i + 2]), p0[i + 3]); } \
        _Pragma("unroll") for (int i = 2; i < 16; i += 4) { rm = fmaxf(fmaxf(rm, p1[i]), p1[i + 1]); rm2 = fmaxf(fmaxf(rm2, p1[(i + 2) & 15]), p1[(i + 3) & 15]); } \
        rm = fmaxf(rm, rm2); \
        { auto rr_ = __builtin_amdgcn_permlane32_swap(__float_as_uint(rm), __float_as_uint(rm), false, false); rm = fmaxf(__uint_as_float(rr_[0]), __uint_as_float(rr_[1])); } \
        resc = false; \
        if (__any((j) == 0 ? (fabsf(rm) > 40.f) : (rm > 60.f))) { \
            const float dl = (j) == 0 ? (fabsf(rm) > 40.f ? rm : 0.f) : (rm > 60.f ? rm : 0.f); \
            mhat += dl; \
            _Pragma("unroll") for (int i = 0; i < 16; ++i) { p0[i] -= dl; p1[i] -= dl; } \
            if ((j) != 0) { rf = __builtin_amdgcn_exp2f(-dl); lsum *= rf; resc = true; } } \
    } while (0)
#define ATT_EXP(PF) do { float sa_ = 0.f, sb_ = 0.f; \
        _Pragma("unroll") for (int i = 0; i < 16; ++i) { p0[i] = __builtin_amdgcn_exp2f(p0[i]); p1[i] = __builtin_amdgcn_exp2f(p1[i]); sa_ += p0[i]; sb_ += p1[i]; } \
        lsum += sa_ + sb_; \
        PF[0] = pack_step(p0, 0); PF[1] = pack_step(p0, 1); PF[2] = pack_step(p1, 0); PF[3] = pack_step(p1, 1); \
    } while (0)
#define ATT_RESC() do { if (resc) { int hic = hi; asm volatile("" : "+v"(hic)); \
        _Pragma("unroll") for (int i = 0; i < 16; ++i) { const float fi = __shfl(rf, crow(i, hic)); \
            _Pragma("unroll") for (int e = 0; e < 4; ++e) o[e][i] *= fi; } } } while (0)
#define ATT_PV(PF, vs_) do { \
        LAS const unsigned char* vb = lds + (vs_) * A_STG + A_KSZ + (4 * hi + tq_) * A_RSV + (16 * blk + 4 * tp_) * 2; \
        _Pragma("unroll") for (int ks = 0; ks < 4; ++ks) { \
            _Pragma("unroll") for (int e = 0; e < 4; ++e) { \
                const v4s lo = tr16(vb + (16 * ks) * A_RSV + e * 64), hh = tr16(vb + (16 * ks + 8) * A_RSV + e * 64); \
                o[e] = MFMA32(PF[ks], cat4(lo, hh), o[e]); } } \
    } while (0)
#define VRD(F, ks) do { _Pragma("unroll") for (int e = 0; e < 4; ++e) { F[2 * e] = tr16(vb + (16 * (ks)) * A_RSV + e * 64); F[2 * e + 1] = tr16(vb + (16 * (ks) + 8) * A_RSV + e * 64); } } while (0)
#define EX2(i) do { p0[i] = __builtin_amdgcn_exp2f(p0[i]); p1[i] = __builtin_amdgcn_exp2f(p1[i]); sa_ += p0[i]; sb_ += p1[i]; } while (0)
#define PVG(PF, ks, F, X0, X1, X2, X3) do { \
        o[0] = MFMA32(PF[ks], cat4(F[0], F[1]), o[0]); X0; SB(); o[1] = MFMA32(PF[ks], cat4(F[2], F[3]), o[1]); X1; SB(); \
        o[2] = MFMA32(PF[ks], cat4(F[4], F[5]), o[2]); X2; SB(); o[3] = MFMA32(PF[ks], cat4(F[6], F[7]), o[3]); X3; SB(); } while (0)
#define ATT_PV_EXP(PF, PFN, vs_) do { \
        LAS const unsigned char* vb = lds + (vs_) * A_STG + A_KSZ + (4 * hi + tq_) * A_RSV + (16 * blk + 4 * tp_) * 2; \
        v4s fa[8], fb[8]; float sa_ = 0.f, sb_ = 0.f; \
        SB(); VRD(fa, 0); SB(); VRD(fb, 1); SB(); \
        PVG(PF, 0, fa, EX2(0), EX2(1), EX2(2), EX2(3)); VRD(fa, 2); SB(); \
        PVG(PF, 1, fb, EX2(4), EX2(5), EX2(6), EX2(7)); VRD(fb, 3); SB(); \
        PVG(PF, 2, fa, EX2(8), do { EX2(9); PFN[0] = pack_step(p0, 0); } while (0), EX2(10), do { EX2(11); PFN[2] = pack_step(p1, 0); } while (0)); \
        PVG(PF, 3, fb, EX2(12), EX2(13), EX2(14), EX2(15)); \
        PFN[1] = pack_step(p0, 1); PFN[3] = pack_step(p1, 1); lsum += sa_ + sb_; \
    } while (0)
#define ATT_ITER(j, PFC, PFN, sv_, sk_) do { \
        if (!SAMPLE) { if ((j) + 2 < ntiles) load_kv((j) + 2, true); if ((j) + 1 < ntiles) load_kv((j) + 1, false); } \
        if (active && (j) < ntw) { \
            if ((j) + 1 < ntw) { \
                QK_TILE(sk_); SB(); \
                ATT_MAX((j) + 1); \
                SB(); \
                ATT_PV_EXP(PFC, PFN, sv_); \
                ATT_RESC(); \
            } else { ATT_PV(PFC, sv_); } \
        } \
        if (SAMPLE) { if ((j) + 2 < ntiles) load_kv((j) + 2, true); if ((j) + 1 < ntiles) load_kv((j) + 1, false); } \
        if ((j) + 2 < ntiles) store_k(sv_); \
        if ((j) + 1 < ntiles) store_v(sk_); \
        __syncthreads(); \
    } while (0)
    load_kv(0, true); load_kv(0, false); store_k(0); store_v(0);
    load_kv(1, true); store_k(1);
    __syncthreads();
    bool resc = false; float rf = 1.f;
    if (active) { QK_TILE(0); ATT_MAX(0); ATT_EXP(pfa); }
    for (int j = 0; j < ntiles; j += 2) {
        ATT_ITER(j, pfa, pfb, 0, 1);
        if (j + 1 < ntiles) ATT_ITER(j + 1, pfb, pfa, 1, 0);
    }
#undef ATT_ITER
#undef ATT_MAX
#undef ATT_EXP
#undef ATT_RESC
#undef ATT_PV
#undef ATT_PV_EXP
#undef PVG
#undef EX2
#undef VRD
#undef SB
#undef QK_TILE
    const int lane2 = fresh_tid(wave_s) & 63, r32b = lane2 & 31, hib = lane2 >> 5;
    LAS float* X = (LAS float*)lds;
    if (active) {
        const int lane_f = lane2;
        float lam;
        { const float a = c.lq1[lane_f] * c.lk1[lane_f], bb = c.lq2[lane_f] * c.lk2[lane_f]; lam = __expf(wave_sum(a)) - __expf(wave_sum(bb)) + 0.2f; }
        lsum += __shfl_xor(lsum, 32);
        const float inv = (mp ? lam : 1.f) / lsum;
#pragma unroll
        for (int i = 0; i < 16; ++i) { const float fi = __shfl(inv, crow(i, hib));
#pragma unroll
            for (int e = 0; e < 4; ++e) o[e][i] *= fi; }
        if (mp) {
#pragma unroll
            for (int e = 0; e < 4; ++e)
#pragma unroll
                for (int i = 0; i < 16; ++i) X[(g * 64 + e * 16 + i) * 64 + lane2] = o[e][i];
        }
    }
    __syncthreads();
    if (active && !mp) {
        bf16* Y = (bf16*)(ws + WS_YD);
        float sg[4];
#pragma unroll
        for (int e = 0; e < 4; ++e) sg[e] = c.subg[32 * e + r32b] * 0.8f;
#pragma unroll
        for (int i = 0; i < 16; ++i) {
            float ss = 0.f;
#pragma unroll
            for (int e = 0; e < 4; ++e) { o[e][i] -= X[(g * 64 + e * 16 + i) * 64 + lane2]; ss += o[e][i] * o[e][i]; }
            ss += __shfl_xor(ss, 1); ss += __shfl_xor(ss, 2); ss += __shfl_xor(ss, 4); ss += __shfl_xor(ss, 8); ss += __shfl_xor(ss, 16);
            const float rstd = 1.f / sqrtf(ss * (1.f / 128.f) + 1e-5f);
            const int ql = crow(i, hib);
            if (STORE && (!SAMPLE || ql < 16)) {
                const size_t row = SAMPLE ? (size_t)ROW_S0 + b * 16 + ql : (size_t)b * SEQ + tq0 + ql;
#pragma unroll
                for (int e = 0; e < 4; ++e) Y[row * D + h * 128 + 32 * e + r32b] = (bf16)f2bf(o[e][i] * rstd * sg[e]); }
        }
    }
    __syncthreads();
}

constexpr int B_RSK = 288, B_KSZ = 64 * B_RSK, B_RSV = 288, B_VSZ = 64 * B_RSV, B_STG = B_KSZ + B_VSZ,     B_BT = 2 * B_STG, B_END = B_BT + 1024;
static_assert(B_END <= LDS_MISC && B_STG * 2 >= 65536, "16x16 attention scratch");
#define MFMA16(a, b, c) __builtin_amdgcn_mfma_f32_16x16x32_bf16((a), (b), (c), 0, 0, 0)
template <bool SAMPLE> __device__ __forceinline__ void attn_unit16(const Ctx& c, LAS unsigned char* lds, int b, int h, int qb, int wave_s) {
    const int tid = fresh_tid(wave_s);
    const int lane = tid & 63, wid = __builtin_amdgcn_readfirstlane(tid >> 6), c16 = lane & 15, q4 = lane >> 4;
    const int g = ((wid >> 1) + 2) & 3, mp = wid & 1;
    const bool active = SAMPLE ? (g == 0) : true;
    constexpr int NQT = SAMPLE ? 1 : 2;
    unsigned char* ws = c.ws;
    LAS float* BT = (LAS float*)(lds + B_BT);
    if (tid < 256) { const int rel = tid - 128; BT[tid] = (c.rel_bias[t5_bucket(rel) * 8 + h] - c.rel_bias[15 * 8 + h]) * LOG2E; }
    const int tq0 = SAMPLE ? PAST : 128 * qb + 32 * g;
    const int ntiles = SAMPLE ? 17 : 2 * qb + 3;
    const int ntw = SAMPLE ? 17 : (tq0 >> 6) + 2;
    bf16x8 qr[2][2];
#pragma unroll
    for (int qt = 0; qt < NQT; ++qt) { const size_t qrow = SAMPLE ? (size_t)ROW_S0 + b * 16 + c16 : (size_t)b * SEQ + tq0 + 16 * qt + c16;
        const bf16* Q = (const bf16*)(ws + WS_DQ) + qrow * D + h * 128 + mp * 64 + q4 * 8;
        qr[qt][0] = *(const bf16x8*)Q; qr[qt][1] = *(const bf16x8*)(Q + 32); }
    const int lrow = tid >> 3, lck = tid & 7;
    u32x4 kreg[2], vreg[2];
    f32x4 kraw[4], vraw[4]; bool kok = true, vok = true;
    auto load_kv = [&](int j, bool isk) {
        u32x4 r0, r1;
        if (SAMPLE) {
            const float* p; bool ok = true;
            if (j < 16) { const size_t rr = ((size_t)b * PAST + 64 * j + lrow) * 8 + h; p = (isk ? c.cache_k : c.cache_v) + rr * 128; }
            else { ok = lrow < 16; const size_t rr = ((size_t)b * 16 + (lrow & 15)) * 8 + h; p = c.out + (isk ? O_KS : O_VS) + rr * 128; }
            if (isk) { kraw[0] = __builtin_nontemporal_load((const f32x4*)(p + lck * 8)); kraw[1] = __builtin_nontemporal_load((const f32x4*)(p + lck * 8 + 4)); kraw[2] = __builtin_nontemporal_load((const f32x4*)(p + 64 + lck * 8)); kraw[3] = __builtin_nontemporal_load((const f32x4*)(p + 64 + lck * 8 + 4)); kok = ok; }
            else     { vraw[0] = __builtin_nontemporal_load((const f32x4*)(p + lck * 8)); vraw[1] = __builtin_nontemporal_load((const f32x4*)(p + lck * 8 + 4)); vraw[2] = __builtin_nontemporal_load((const f32x4*)(p + 64 + lck * 8)); vraw[3] = __builtin_nontemporal_load((const f32x4*)(p + 64 + lck * 8 + 4)); vok = ok; }
            return;
        }
        if (!SAMPLE) {
            const int kidx0 = j == 0 ? 0 : 16 + 64 * (j - 1);
            const size_t rr = (size_t)(b * 8 + h) * KROWS + kidx0 + lrow;
            const bf16* p = (const bf16*)(ws + (isk ? WS_DK : WS_DV)) + rr * 128;
            r0 = *(const u32x4*)(p + lck * 8); r1 = *(const u32x4*)(p + 64 + lck * 8);
        } else {
            const float* p; bool ok = true;
            if (j < 16) { const size_t rr = ((size_t)b * PAST + 64 * j + lrow) * 8 + h; p = (isk ? c.cache_k : c.cache_v) + rr * 128; }
            else { ok = lrow < 16; const size_t rr = ((size_t)b * 16 + (lrow & 15)) * 8 + h; p = c.out + (isk ? O_KS : O_VS) + rr * 128; }
            r0 = pack8(*(const f32x4*)(p + lck * 8), *(const f32x4*)(p + lck * 8 + 4)); r1 = pack8(*(const f32x4*)(p + 64 + lck * 8), *(const f32x4*)(p + 64 + lck * 8 + 4));
            if (!ok) { r0 = (u32x4){0u, 0u, 0u, 0u}; r1 = r0; }
        }
        if (isk) { kreg[0] = r0; kreg[1] = r1; } else { vreg[0] = r0; vreg[1] = r1; }
    };
    auto store_k = [&](int slot) { if (SAMPLE) { kreg[0] = pack8(kraw[0], kraw[1]); kreg[1] = pack8(kraw[2], kraw[3]); if (!kok) { kreg[0] = (u32x4){0u, 0u, 0u, 0u}; kreg[1] = kreg[0]; } }
        LAS unsigned char* kb = lds + slot * B_STG + lrow * B_RSK + lck * 16; *(LAS u32x4*)kb = kreg[0]; *(LAS u32x4*)(kb + 128) = kreg[1]; };
    auto store_v = [&](int slot) { if (SAMPLE) { vreg[0] = pack8(vraw[0], vraw[1]); vreg[1] = pack8(vraw[2], vraw[3]); if (!vok) { vreg[0] = (u32x4){0u, 0u, 0u, 0u}; vreg[1] = vreg[0]; } }
        LAS unsigned char* vb = lds + slot * B_STG + B_KSZ + lrow * B_RSV + lck * 16; *(LAS u32x4*)vb = vreg[0]; *(LAS u32x4*)(vb + 128) = vreg[1]; };
    f32x4 o[2][8], p[2][4];
#pragma unroll
    for (int qt = 0; qt < NQT; ++qt)
#pragma unroll
        for (int et = 0; et < 8; ++et) o[qt][et] = (f32x4){0.f, 0.f, 0.f, 0.f};
    float ls[2] = {0.f, 0.f}, mh[2] = {0.f, 0.f}, rf[2] = {1.f, 1.f};
    bool resc = false;
    bf16x8 pfa[2][2], pfb[2][2];
    const int tq_ = c16 >> 2, tp_ = c16 & 3;
    const f32x4 zero4 = {0.f, 0.f, 0.f, 0.f};
#define SB() __builtin_amdgcn_sched_barrier(0)
#define QK16(ks_) do { LAS const unsigned char* kb_ = lds + (ks_) * B_STG + mp * 128 + c16 * B_RSK + q4 * 16; bf16x8 kf_[4][2]; \
        SB(); \
        _Pragma("unroll") for (int kt = 0; kt < 4; ++kt) { kf_[kt][0] = *(LAS const bf16x8*)(kb_ + kt * 16 * B_RSK); kf_[kt][1] = *(LAS const bf16x8*)(kb_ + kt * 16 * B_RSK + 64); } \
        SB(); \
        _Pragma("unroll") for (int kt = 0; kt < 4; ++kt) _Pragma("unroll") for (int qt = 0; qt < NQT; ++qt) p[qt][kt] = MFMA16(kf_[kt][0], qr[qt][0], zero4); \
        _Pragma("unroll") for (int kt = 0; kt < 4; ++kt) _Pragma("unroll") for (int qt = 0; qt < NQT; ++qt) p[qt][kt] = MFMA16(kf_[kt][1], qr[qt][1], p[qt][kt]); \
        SB(); \
        if (__any(mh[0] != 0.f || (NQT > 1 && mh[1] != 0.f))) { _Pragma("unroll") for (int qt = 0; qt < NQT; ++qt) _Pragma("unroll") for (int kt = 0; kt < 4; ++kt) p[qt][kt] = p[qt][kt] - mh[qt]; } } while (0)
#define MAX16(j) do { \
        const int kpos0 = SAMPLE ? 64 * (j) : ((j) == 0 ? -16 : 64 * ((j) - 1)); \
        const bool partial = SAMPLE ? ((j) == 16) : ((j) == 0); \
        if (kpos0 + 63 - tq0 > -91 - 31 || partial) { \
            _Pragma("unroll") for (int qt = 0; qt < NQT; ++qt) { const int tqv = SAMPLE ? PAST + c16 : tq0 + 16 * qt + c16; const int base = kpos0 - tqv + 128 + 4 * q4; \
                _Pragma("unroll") for (int kt = 0; kt < 4; ++kt) _Pragma("unroll") for (int i = 0; i < 4; ++i) { int ix = base + 16 * kt + i; ix = ix < 0 ? 0 : (ix > 255 ? 255 : ix); p[qt][kt][i] += BT[ix]; } } } \
        if (partial) { _Pragma("unroll") for (int qt = 0; qt < NQT; ++qt) _Pragma("unroll") for (int kt = 1; kt < 4; ++kt) p[qt][kt] = (f32x4){-INFINITY, -INFINITY, -INFINITY, -INFINITY}; } \
        float m_[2] = {0.f, 0.f}; \
        _Pragma("unroll") for (int qt = 0; qt < NQT; ++qt) { float a_ = fmaxf(fmaxf(p[qt][0][0], p[qt][0][1]), p[qt][0][2]), b_ = fmaxf(fmaxf(p[qt][0][3], p[qt][1][0]), p[qt][1][1]); \
            a_ = fmaxf(fmaxf(a_, p[qt][1][2]), p[qt][1][3]); b_ = fmaxf(fmaxf(b_, p[qt][2][0]), p[qt][2][1]); a_ = fmaxf(fmaxf(a_, p[qt][2][2]), p[qt][2][3]); \
            b_ = fmaxf(fmaxf(b_, p[qt][3][0]), p[qt][3][1]); a_ = fmaxf(fmaxf(a_, p[qt][3][2]), p[qt][3][3]); m_[qt] = fmaxf(a_, b_); } \
        resc = false; \
        const float mm_ = NQT > 1 ? fmaxf(m_[0], m_[1]) : m_[0]; \
        if (__any((j) == 0 ? (fabsf(m_[0]) > 40.f || (NQT > 1 && fabsf(m_[1]) > 40.f)) : (mm_ > 60.f))) { \
            _Pragma("unroll") for (int qt = 0; qt < NQT; ++qt) { float rm = fmaxf(m_[qt], __shfl_xor(m_[qt], 16)); rm = fmaxf(rm, __shfl_xor(rm, 32)); \
                const float dl = (j) == 0 ? (fabsf(rm) > 40.f ? rm : 0.f) : (rm > 60.f ? rm : 0.f); \
                mh[qt] += dl; \
                _Pragma("unroll") for (int kt = 0; kt < 4; ++kt) p[qt][kt] = p[qt][kt] - dl; \
                rf[qt] = __builtin_amdgcn_exp2f(-dl); if ((j) != 0) ls[qt] *= rf[qt]; } \
            resc = (j) != 0; } \
    } while (0)
#define EXP1(s_) do { const int qt_ = (s_) >> 4, kt_ = ((s_) >> 2) & 3, i_ = (s_) & 3; p[qt_][kt_][i_] = __builtin_amdgcn_exp2f(p[qt_][kt_][i_]); ls[qt_] += p[qt_][kt_][i_]; } while (0)
#define PACK16(PF, qt_, kp_) do { u32x4 w_; w_.x = cvt_pk_bf16(p[qt_][2 * (kp_)][0], p[qt_][2 * (kp_)][1]); w_.y = cvt_pk_bf16(p[qt_][2 * (kp_)][2], p[qt_][2 * (kp_)][3]); \
        w_.z = cvt_pk_bf16(p[qt_][2 * (kp_) + 1][0], p[qt_][2 * (kp_) + 1][1]); w_.w = cvt_pk_bf16(p[qt_][2 * (kp_) + 1][2], p[qt_][2 * (kp_) + 1][3]); PF[qt_][kp_] = __builtin_bit_cast(bf16x8, w_); } while (0)
#define EXPALL(PF) do { _Pragma("unroll") for (int s_ = 0; s_ < 16 * NQT; ++s_) EXP1(s_); PACK16(PF, 0, 0); PACK16(PF, 0, 1); if (NQT > 1) { PACK16(PF, 1, 0); PACK16(PF, 1, 1); } } while (0)
#define VRD16(F, kp_, eh_) do { _Pragma("unroll") for (int e4 = 0; e4 < 4; ++e4) { F[2 * e4] = tr16(vb + (32 * (kp_)) * B_RSV + (4 * (eh_) + e4) * 32); F[2 * e4 + 1] = tr16(vb + (32 * (kp_) + 16) * B_RSV + (4 * (eh_) + e4) * 32); } } while (0)
#define PVG16(PF, kp_, eh_, F, WITHX, sb_) do { _Pragma("unroll") for (int e4 = 0; e4 < 4; ++e4) _Pragma("unroll") for (int qt = 0; qt < NQT; ++qt) { \
        o[qt][4 * (eh_) + e4] = MFMA16(PF[qt][kp_], cat4(F[2 * e4], F[2 * e4 + 1]), o[qt][4 * (eh_) + e4]); if (WITHX) EXP1((sb_) + 2 * e4 + qt); SB(); } } while (0)
#define PV16(PF, PFN, vs_, WITHX) do { \
        LAS const unsigned char* vb = lds + (vs_) * B_STG + B_KSZ + (4 * q4 + tq_) * B_RSV + tp_ * 8; \
        v4s fa[8]; \
        SB(); VRD16(fa, 0, 0); SB(); \
        PVG16(PF, 0, 0, fa, WITHX, 0); VRD16(fa, 0, 1); if (WITHX) PACK16(PFN, 0, 0); SB(); \
        PVG16(PF, 0, 1, fa, WITHX, 8); VRD16(fa, 1, 0); if (WITHX) PACK16(PFN, 0, 1); SB(); \
        PVG16(PF, 1, 0, fa, WITHX, 16); VRD16(fa, 1, 1); if (WITHX) PACK16(PFN, 1, 0); SB(); \
        PVG16(PF, 1, 1, fa, WITHX, 24); if (WITHX) PACK16(PFN, 1, 1); SB(); \
    } while (0)
#define RESC16() do { if (resc) { int q4c = q4; asm volatile("" : "+v"(q4c)); \
        _Pragma("unroll") for (int qt = 0; qt < NQT; ++qt) _Pragma("unroll") for (int i = 0; i < 4; ++i) { const float fi = __shfl(rf[qt], 4 * q4c + i); \
            _Pragma("unroll") for (int et = 0; et < 8; ++et) o[qt][et][i] *= fi; } } } while (0)
#define ITER16(j, PFC, PFN, sv_, sk_) do { \
        { if ((j) + 2 < ntiles) load_kv((j) + 2, true); if ((j) + 1 < ntiles) load_kv((j) + 1, false); } \
        if (active && (j) < ntw) { \
            if ((j) + 1 < ntw) { QK16(sk_); MAX16((j) + 1); SB(); if (SAMPLE) { PV16(PFC, PFN, sv_, false); EXPALL(PFN); } else { PV16(PFC, PFN, sv_, true); } RESC16(); } \
            else { PV16(PFC, PFN, sv_, false); } \
        } \
        if ((j) + 2 < ntiles) store_k(sv_); \
        if ((j) + 1 < ntiles) store_v(sk_); \
        __syncthreads(); \
    } while (0)
    if (SAMPLE) { load_kv(0, true); load_kv(0, false); store_k(0); store_v(0); load_kv(1, true); store_k(1); }
    else { load_kv(0, true); const u32x4 k0a = kreg[0], k0b = kreg[1];
      load_kv(0, false); load_kv(1, true);
      LAS unsigned char* kb0 = lds + lrow * B_RSK + lck * 16; *(LAS u32x4*)kb0 = k0a; *(LAS u32x4*)(kb0 + 128) = k0b;
      store_v(0); store_k(1); }
    __syncthreads();
    if (active) { QK16(0); MAX16(0); EXPALL(pfa); }
    for (int j = 0; j < ntiles; j += 2) {
        ITER16(j, pfa, pfb, 0, 1);
        if (j + 1 < ntiles) ITER16(j + 1, pfb, pfa, 1, 0);
    }
#undef ITER16
#undef RESC16
#undef PV16
#undef PVG16
#undef VRD16
#undef EXPALL
#undef PACK16
#undef EXP1
#undef MAX16
#undef QK16
#undef SB
    const int lane2 = fresh_tid(wave_s) & 63, c16b = lane2 & 15, q4b = lane2 >> 4;
    LAS float* X = (LAS float*)lds;
    if (active) {
        float lam;
        { const float a = c.lq1[lane2] * c.lk1[lane2], bb = c.lq2[lane2] * c.lk2[lane2]; lam = __expf(wave_sum(a)) - __expf(wave_sum(bb)) + 0.2f; }
#pragma unroll
        for (int qt = 0; qt < NQT; ++qt) { float l = ls[qt] + __shfl_xor(ls[qt], 16); l += __shfl_xor(l, 32);
            const float inv = (mp ? lam : 1.f) / l;
#pragma unroll
            for (int i = 0; i < 4; ++i) { const float fi = __shfl(inv, 4 * q4b + i);
#pragma unroll
                for (int et = 0; et < 8; ++et) o[qt][et][i] *= fi; } }
        if (mp) {
#pragma unroll
            for (int qt = 0; qt < NQT; ++qt)
#pragma unroll
                for (int et = 0; et < 8; ++et)
#pragma unroll
                    for (int i = 0; i < 4; ++i) X[(g * 64 + qt * 32 + et * 4 + i) * 64 + lane2] = o[qt][et][i];
        }
    }
    __syncthreads();
    if (active && !mp) {
        bf16* Y = (bf16*)(ws + WS_YD);
        float sg[8];
#pragma unroll
        for (int et = 0; et < 8; ++et) sg[et] = c.subg[16 * et + c16b] * 0.8f;
#pragma unroll
        for (int qt = 0; qt < (SAMPLE ? 1 : 2); ++qt)
#pragma unroll
            for (int i = 0; i < 4; ++i) {
                float ss = 0.f;
#pragma unroll
                for (int et = 0; et < 8; ++et) { o[qt][et][i] -= X[(g * 64 + qt * 32 + et * 4 + i) * 64 + lane2]; ss += o[qt][et][i] * o[qt][et][i]; }
                ss += __shfl_xor(ss, 1); ss += __shfl_xor(ss, 2); ss += __shfl_xor(ss, 4); ss += __shfl_xor(ss, 8);
                const float rstd = 1.f / sqrtf(ss * (1.f / 128.f) + 1e-5f);
                const int ql = 16 * qt + 4 * q4b + i;
                const size_t row = SAMPLE ? (size_t)ROW_S0 + b * 16 + ql : (size_t)b * SEQ + tq0 + ql;
#pragma unroll
                for (int et = 0; et < 8; ++et) Y[row * D + h * 128 + 16 * et + c16b] = (bf16)f2bf(o[qt][et][i] * rstd * sg[et]);
            }
    }
    __syncthreads();
}

constexpr int R_RSQ = 272, R_RSKP = 320, R_RSV = 576, R_RSP = 144, R_RSG = 528;
constexpr int R_Q = 0, R_K = R_Q + 64 * R_RSQ, R_KP = R_K + 64 * R_RSQ, R_V = R_KP + 64 * R_RSKP, R_P = R_V + 64 * R_RSV, R_PS = R_P + 64 * R_RSP, R_RST = R_PS + 2048, R_RG = R_RST + 256, R_END = R_RG + 64 * R_RSG;
static_assert(R_END <= LDS_MISC && A_END <= LDS_MISC, "phase scratch fits below the LDS control words");
constexpr int NSEG = 8, CPS = 128 / NSEG;
constexpr int CW_FLAGS = 9216;
template <int MODE, bool STORE = true> __device__ __forceinline__ void ret_unit(const Ctx& c, LAS unsigned char* lds, int b, int h, int seg, int wave_s) {
    constexpr bool SAMPLE = MODE == 1;
    const int tid = fresh_tid(wave_s);
    const int lane = tid & 63, w = __builtin_amdgcn_readfirstlane(tid >> 6), r32 = lane & 31, hi = lane >> 5;
    unsigned char* ws = c.ws;
    unsigned* ctl = (unsigned*)(ws + WS_CTL);
    const float lg2 = log2f(1.f - exp2f(-5.f - (float)h));
    constexpr int LCH = SAMPLE ? 16 : 64;
    const float gL = exp2f(lg2 * (float)LCH);
    const int nch = MODE == 1 ? 1 : (MODE == 0 ? CPS + 1 : CPS);
    float* LS = (float*)(ws + WS_LS);
    f32x16 S[4];
    if (SAMPLE) { const float* sp = c.state_ret + ((size_t)(b * 4 + h) * 128 + 4 * hi) * 256 + 32 * w + r32;
#pragma unroll
        for (int dt = 0; dt < 4; ++dt) {
            __builtin_amdgcn_sched_barrier(0);
#pragma unroll
            for (int i = 0; i < 16; ++i) S[dt][i] = sp[(32 * dt + crow(i, 0)) * 256]; }
    } else {
#pragma unroll
        for (int dt = 0; dt < 4; ++dt)
#pragma unroll
            for (int i = 0; i < 16; ++i) S[dt][i] = 0.f;
    }
    const int lrow = tid >> 3, lck = tid & 7;
    u32x4 qreg[2], kreg[2], vreg[4], greg[4];
    auto chunk_row = [&](int ch, bool& ok) -> size_t {
        ok = true;
        if (SAMPLE) { ok = lrow < 16; return (size_t)ROW_S0 + b * 16 + (lrow & 15); }
        if (MODE == 0 && ch == 0) { ok = lrow < 16; return (size_t)ROW_M0 + (lrow & 15); }
        return (size_t)b * SEQ + 64 * (seg * CPS + (MODE == 0 ? ch - 1 : ch)) + lrow;
    };
    auto load_chunk = [&](int ch) {
        bool ok; const size_t row = chunk_row(ch, ok);
        const bf16* qp = (const bf16*)(ws + WS_QR) + row * 512 + h * 128; const bf16* kp = (const bf16*)(ws + WS_KR) + row * 512 + h * 128; const bf16* vp = (const bf16*)(ws + WS_VR) + row * D + h * 256;
#pragma unroll
        for (int t = 0; t < 2; ++t) { if (MODE != 2) qreg[t] = *(const u32x4*)(qp + t * 64 + lck * 8); kreg[t] = *(const u32x4*)(kp + t * 64 + lck * 8); }
#pragma unroll
        for (int t = 0; t < 4; ++t) vreg[t] = *(const u32x4*)(vp + t * 64 + lck * 8);
        if (!ok) {
#pragma unroll
            for (int t = 0; t < 2; ++t) { qreg[t] = (u32x4){0u, 0u, 0u, 0u}; kreg[t] = (u32x4){0u, 0u, 0u, 0u}; }
#pragma unroll
            for (int t = 0; t < 4; ++t) vreg[t] = (u32x4){0u, 0u, 0u, 0u}; }
    };
    auto store_chunk = [&](int ch) {
        const bool short_ch = SAMPLE || (MODE == 0 && ch == 0);
        const float kd = exp2f(lg2 * (float)((short_ch ? 15 : 63) - lrow));
#pragma unroll
        for (int t = 0; t < 2; ++t) {
            if (MODE != 2) { *(LAS u32x4*)(lds + R_Q + lrow * R_RSQ + t * 128 + lck * 16) = qreg[t];
                             *(LAS u32x4*)(lds + R_K + lrow * R_RSQ + t * 128 + lck * 16) = kreg[t]; }
            float f[8]; unpack8(kreg[t], f); u32x4 kp;
            kp.x = cvt_pk_bf16(f[0] * kd, f[1] * kd); kp.y = cvt_pk_bf16(f[2] * kd, f[3] * kd); kp.z = cvt_pk_bf16(f[4] * kd, f[5] * kd); kp.w = cvt_pk_bf16(f[6] * kd, f[7] * kd);
            *(LAS u32x4*)(lds + R_KP + lrow * R_RSKP + t * 128 + lck * 16) = kp; }
#pragma unroll
        for (int t = 0; t < 4; ++t) *(LAS u32x4*)(lds + R_V + lrow * R_RSV + t * 128 + lck * 16) = vreg[t];
    };
    const int i16 = lane & 15, tq_ = i16 >> 2, tp_ = i16 & 3, blk = (lane >> 4) & 1;
    load_chunk(0); store_chunk(0);
    __syncthreads();
    for (int ch = 0; ch < nch; ++ch) {
        const bool state_only = MODE == 2 || (MODE == 0 && ch == 0);
        float lgc = lg2; int hic = hi, r32c = r32; asm volatile("" : "+v"(lgc), "+v"(hic), "+v"(r32c));
        f32x16 O[2];
        bf16x8 vf[4];
        { LAS const unsigned char* vb = lds + R_V + (8 * hi + tq_) * R_RSV + (32 * w + 16 * blk + 4 * tp_) * 2;
#pragma unroll
          for (int s = 0; s < 4; ++s) vf[s] = cat4(tr16(vb + (16 * s) * R_RSV), tr16(vb + (16 * s + 4) * R_RSV)); }
        if (!state_only) {
            if (w < 4) { const int mt = w >> 1, lt = w & 1; f32x16 x;
#pragma unroll
                for (int i = 0; i < 16; ++i) x[i] = 0.f;
                LAS const unsigned char* ka = lds + R_K + (32 * mt + r32) * R_RSQ + hi * 16; LAS const unsigned char* qb_ = lds + R_Q + (32 * lt + r32) * R_RSQ + hi * 16;
#pragma unroll
                for (int s = 0; s < 8; ++s) { if ((s & 3) == 0) __builtin_amdgcn_sched_barrier(0); x = MFMA32(*(LAS const bf16x8*)(ka + 32 * s), *(LAS const bf16x8*)(qb_ + 32 * s), x); }
                const int l = 32 * lt + r32c;
#pragma unroll
                for (int i = 0; i < 16; ++i) { const int m = 32 * mt + crow(i, hic); const int dlt = l > m ? l - m : m - l; x[i] *= __builtin_amdgcn_exp2f(lgc * (float)dlt); }
#pragma unroll
                for (int q4 = 0; q4 < 4; ++q4) { u32x2 pk; pk.x = cvt_pk_bf16(x[4 * q4], x[4 * q4 + 1]); pk.y = cvt_pk_bf16(x[4 * q4 + 2], x[4 * q4 + 3]);
                    *(LAS u32x2*)(lds + R_P + (32 * lt + r32) * R_RSP + (32 * mt + 8 * q4 + 4 * hi) * 2) = pk; }
            }
            __builtin_amdgcn_sched_barrier(0);
#pragma unroll
            for (int lt = 0; lt < 2; ++lt) {
#pragma unroll
                for (int i = 0; i < 16; ++i) O[lt][i] = 0.f; }
#pragma unroll
            for (int dt = 0; dt < 4; ++dt) {
                __builtin_amdgcn_sched_barrier(0);
#pragma unroll
                for (int s = 0; s < 2; ++s) { const bf16x8 sb = pack_step(S[dt], s);
#pragma unroll
                    for (int lt = 0; lt < 2; ++lt) { LAS const unsigned char* qa = lds + R_Q + (32 * lt + r32) * R_RSQ + (32 * dt + 16 * s + 4 * hi) * 2;
                        const v4s a0 = *(LAS const v4s*)qa, a1 = *(LAS const v4s*)(qa + 16);
                        O[lt] = MFMA32(cat4(a0, a1), sb, O[lt]); } } }
#pragma unroll
            for (int lt = 0; lt < 2; ++lt)
#pragma unroll
                for (int i = 0; i < 16; ++i) O[lt][i] *= __builtin_amdgcn_exp2f(lgc * (float)(32 * lt + crow(i, hic) + 1));
            __syncthreads();
#pragma unroll
            for (int lt = 0; lt < 2; ++lt) { LAS const unsigned char* pa = lds + R_P + (32 * lt + r32) * R_RSP + hi * 16;
#pragma unroll
                for (int s = 0; s < 4; ++s) O[lt] = MFMA32(*(LAS const bf16x8*)(pa + 32 * s), vf[s], O[lt]); }
        }
#pragma unroll
        for (int dt = 0; dt < 4; ++dt) {
            if ((dt & 1) == 0) __builtin_amdgcn_sched_barrier(0);
#pragma unroll
            for (int i = 0; i < 16; ++i) S[dt][i] *= gL;
            LAS const unsigned char* ka = lds + R_KP + (8 * hi + tq_) * R_RSKP + (32 * dt + 16 * blk + 4 * tp_) * 2;
#pragma unroll
            for (int s = 0; s < 4; ++s) S[dt] = MFMA32(cat4(tr16(ka + (16 * s) * R_RSKP), tr16(ka + (16 * s + 4) * R_RSKP)), vf[s], S[dt]); }
        __builtin_amdgcn_sched_barrier(0);
        if (ch + 1 < nch) load_chunk(ch + 1);
        if (!state_only) {
            { bool ok; const size_t row = chunk_row(ch, ok); const bf16* gp = (const bf16*)(ws + WS_RG) + row * D + h * 256;
#pragma unroll
              for (int t = 0; t < 4; ++t) greg[t] = __builtin_nontemporal_load((const u32x4*)(gp + t * 64 + lck * 8)); }
            __builtin_amdgcn_sched_barrier(0);
            LAS float* PS = (LAS float*)(lds + R_PS); LAS float* RST = (LAS float*)(lds + R_RST);
            { float v[32];
#pragma unroll
              for (int lt = 0; lt < 2; ++lt)
#pragma unroll
                  for (int i = 0; i < 16; ++i) v[lt * 16 + i] = O[lt][i] * O[lt][i];
#pragma unroll
              for (int st = 0; st < 5; ++st) { const int m = 16 >> st, n = 32 >> st; const bool up = (r32 & m) != 0;
#pragma unroll
                  for (int k = 0; k < n / 2; ++k) { const float send = up ? v[k] : v[k + n / 2], keep = up ? v[k + n / 2] : v[k]; v[k] = keep + __shfl_xor(send, m); } }
              PS[w * 64 + 32 * (r32 >> 4) + crow(r32 & 15, hi)] = v[0]; }
            __syncthreads();
            if (tid < 64) { float t = 0.f;
#pragma unroll
                for (int ww = 0; ww < 8; ++ww) t += PS[ww * 64 + tid];
                RST[tid] = 1.f / sqrtf(t * (1.f / 256.f) + 1e-6f); }
#pragma unroll
            for (int t = 0; t < 4; ++t) *(LAS u32x4*)(lds + R_RG + lrow * R_RSG + t * 128 + lck * 16) = greg[t];
            __syncthreads();
            LAS unsigned short* GT = (LAS unsigned short*)(lds + R_RG) + 32 * w + r32;
#pragma unroll
            for (int lt = 0; lt < 2; ++lt)
#pragma unroll
                for (int i = 0; i < 16; ++i) { const int l = 32 * lt + crow(i, hi);
                    GT[l * (R_RSG / 2)] = (unsigned short)f2bf(O[lt][i] * RST[l] * silu_f(bf2f(GT[l * (R_RSG / 2)]))); }
            __syncthreads();
            { bool ok; const size_t row = chunk_row(ch, ok); bf16* yp = (bf16*)(ws + WS_VR) + row * D + h * 256;
              if (ok && STORE) {
#pragma unroll
                  for (int t = 0; t < 4; ++t) *(u32x4*)(yp + t * 64 + lck * 8) = *(LAS const u32x4*)(lds + R_RG + lrow * R_RSG + t * 128 + lck * 16); } }
        } else {
            __syncthreads();
        }
        if (MODE == 0 && ch == 0 && seg > 0) {
            if (tid == 0) {
                for (int sp = 0; sp < seg; ++sp) { unsigned* fl = ctl + CW_FLAGS + (b * 4 + h) * 16 + sp; unsigned spin = 0;
                    while (__hip_atomic_load(fl, __ATOMIC_RELAXED, __HIP_MEMORY_SCOPE_AGENT) == 0u) { __builtin_amdgcn_s_sleep(2); if (++spin > (1u << 24)) break; } }
                __builtin_amdgcn_fence(__ATOMIC_ACQUIRE, "agent");
                asm volatile("s_waitcnt vmcnt(0)" ::: "memory");
            }
            __syncthreads();
            const float gS = exp2f(lg2 * (float)(64 * CPS) * (float)seg);
#pragma unroll
            for (int dt = 0; dt < 4; ++dt)
#pragma unroll
                for (int i = 0; i < 16; ++i) S[dt][i] *= gS;
            for (int sp = 0; sp < seg; ++sp) {
                const float cf = exp2f(lg2 * (float)(64 * CPS) * (float)(seg - 1 - sp));
                if (cf < 1e-12f) continue;
                const float* L = LS + ((size_t)((b * 4 + h) * NSEG + sp)) * 32768 + w * 64 + lane;
                f32x16 t[4];
#pragma unroll
                for (int dt = 0; dt < 4; ++dt)
#pragma unroll
                    for (int i = 0; i < 16; ++i) t[dt][i] = __builtin_nontemporal_load(L + (dt * 16 + i) * 512);
#pragma unroll
                for (int dt = 0; dt < 4; ++dt)
#pragma unroll
                    for (int i = 0; i < 16; ++i) S[dt][i] += cf * t[dt][i];
            }
        }
        if (ch + 1 < nch) { store_chunk(ch + 1); __syncthreads(); }
    }
    if (!STORE) { __syncthreads(); return; }
    if (MODE == 2) {
        float* L = LS + ((size_t)((b * 4 + h) * NSEG + seg)) * 32768 + w * 64 + lane;
#pragma unroll
        for (int dt = 0; dt < 4; ++dt)
#pragma unroll
            for (int i = 0; i < 16; ++i) L[(dt * 16 + i) * 512] = S[dt][i];
        asm volatile("s_waitcnt vmcnt(0)" ::: "memory");
        __syncthreads();
        if (tid == 0) { __builtin_amdgcn_fence(__ATOMIC_RELEASE, "agent"); asm volatile("s_waitcnt vmcnt(0)" ::: "memory");
            __hip_atomic_store(ctl + CW_FLAGS + (b * 4 + h) * 16 + seg, 1u, __ATOMIC_RELAXED, __HIP_MEMORY_SCOPE_AGENT); }
    } else if (SAMPLE || seg == NSEG - 1) {
        int hio = hi; asm volatile("" : "+v"(hio));
        float* so = c.out + (SAMPLE ? O_SS : O_SP) + ((size_t)(b * 4 + h) * 128 + 4 * hio) * 256 + 32 * w + r32;
#pragma unroll
        for (int dt = 0; dt < 4; ++dt) {
            __builtin_amdgcn_sched_barrier(0);
#pragma unroll
            for (int i = 0; i < 16; ++i) so[(32 * dt + crow(i, 0)) * 256] = S[dt][i]; }
    }
    __syncthreads();
}
__global__ void __launch_bounds__(512, 2) hybrid_fwd(Ctx c) {
    extern __shared__ __attribute__((aligned(16))) unsigned char lds_raw[];
    LAS unsigned char* lds = (LAS unsigned char*)lds_raw;
    const int wave0 = __builtin_amdgcn_readfirstlane(threadIdx.x >> 6);
    const int G = gridDim.x, bx = blockIdx.x, vcu = (G % 8 == 0) ? (bx % 8) * (G / 8) + bx / 8 : bx;
    volatile LAS unsigned* MISC = (volatile LAS unsigned*)(lds + LDS_MISC);
    { const int t0 = fresh_tid(wave0); if (t0 < 64) MISC[t0] = 0u; }
    __syncthreads();
    unsigned* ctl = (unsigned*)(c.ws + WS_CTL);
    XcdBarrier bar = xcd_barrier_post(ctl, MISC + 8, wave0);
    unsigned char* ws = c.ws;

    p0_prep(c, lds, vcu, G, wave0);
    if (G == 0x7fffffff) cg::this_grid().sync();
    xcd_barrier(bar);

#ifdef PROBE_G
    for (int rep_ = 0; rep_ < 2; ++rep_)
#endif
    { pg8::Gemm g{(const pg8::bf16_t*)(ws + WS_XN), (const pg8::bf16_t*)(ws + WS_WIN), R_ALL, 8192, D}; pg8::StaticOrder S; S.init(R_ALL, 8192, G, bx);
      EpiIn E{c}; pg8::gemm_phase<EpiIn, pg8::StaticOrder, true, true>(lds, g, S, E, wave0); }
    xcd_barrier(bar);

    {
        for (;;) {
            if (fresh_tid(wave0) == 0) MISC[16] = atomicAdd(ctl + CW_QUEUE, 1u);
            __syncthreads();
            const int it = (int)MISC[16];
            __syncthreads();
            if (it >= 432) break;
            if (it < 112) { const int bh = it / 7, sg = it % 7; ret_unit<2>(c, lds, bh >> 2, bh & 3, sg, wave0); }
            else if (it < 240) { const int k = it - 112, bh = k >> 3, sg = k & 7; ret_unit<0>(c, lds, bh >> 2, bh & 3, sg, wave0); }
            else if (it < 304) ret_unit<1>(c, lds, (it - 240) >> 2, (it - 240) & 3, 0, wave0);
            else attn_unit16<true>(c, lds, (it - 304) >> 3, (it - 304) & 7, 0, wave0);
        }
        const int x0 = (int)(xb_xcc_id() & 7u);
        for (int kx = 0; kx < 8; ++kx) {
            const int xq = (x0 + kx) & 7;
            for (;;) {
                if (fresh_tid(wave0) == 0) MISC[16] = atomicAdd(ctl + CW_XQ + 64 * xq, 1u);
                __syncthreads();
                const int it = (int)MISC[16];
                __syncthreads();
                if (it >= 128) break;
                const int bh = 4 * xq + (it >> 5), pp = it & 31;
#ifdef PROBE_A
                attn_unit<false, false>(c, lds, bh >> 3, bh & 7, 63 - pp, wave0);
                attn_unit<false, false>(c, lds, bh >> 3, bh & 7, pp, wave0);
#endif
                attn_unit16<false>(c, lds, bh >> 3, bh & 7, 63 - pp, wave0);
                attn_unit16<false>(c, lds, bh >> 3, bh & 7, pp, wave0);
            }
        }
    }
    xcd_barrier(bar);

    bf16* MG = (bf16*)(ws + WS_MG);
    for (int u = bx; u < 256; u += G) {
        const int rg = u & 7, cg = u >> 3;
        const bf16* const Bs[1] = {(const bf16*)(ws + WS_WRB) + (size_t)(32 * cg) * D};
        small_gemm<1>((const bf16*)(ws + WS_VR), D, Bs, rg, wave0, lds, [&](const float (&v)[1][2], int w, int r32, int hi) {
            const int col = 32 * cg + r32;
#pragma unroll
            for (int ii = 0; ii < 2; ++ii) { const int row = ROW_S0 + 32 * rg + crow(2 * w + ii, hi);
                MG[(size_t)row * D + col] = (bf16)f2bf(bf2f(gate_row(c, 0, row)[col]) * v[0][ii]); } });
    }
    { pg8::Gemm g{(const pg8::bf16_t*)(ws + WS_VR), (const pg8::bf16_t*)(ws + WS_WRB), ROW_S0, D, D}; pg8::StaticOrder S; S.init(ROW_S0, D, G, bx);
      EpiBranch<0> E{c}; pg8::gemm_phase<EpiBranch<0>, pg8::StaticOrder, true, true>(lds, g, S, E, wave0); }
    for (int u = bx; u < 256; u += G) {
        const int rg = u & 7, cg = u >> 3;
        const bf16* const Bs[1] = {(const bf16*)(ws + WS_WDB) + (size_t)(32 * cg) * D};
        small_gemm<1>((const bf16*)(ws + WS_YD), D, Bs, rg, wave0, lds, [&](const float (&v)[1][2], int w, int r32, int hi) {
            const int col = 32 * cg + r32;
#pragma unroll
            for (int ii = 0; ii < 2; ++ii) { const int row = ROW_S0 + 32 * rg + crow(2 * w + ii, hi); const size_t idx = (size_t)row * D + col;
                MG[idx] = (bf16)f2bf(bf2f(MG[idx]) + bf2f(gate_row(c, 1, row)[col]) * v[0][ii]); } });
    }
    { pg8::Gemm g{(const pg8::bf16_t*)(ws + WS_YD), (const pg8::bf16_t*)(ws + WS_WDB), ROW_S0, D, D}; pg8::StaticOrder S; S.init(ROW_S0, D, G, bx);
      EpiBranch<1> E{c}; pg8::gemm_phase<EpiBranch<1>, pg8::StaticOrder, true, true>(lds, g, S, E, wave0); }
    xcd_barrier(bar);
    for (int u = bx; u < 128; u += G) {
        const int rg = u & 7, cg = u >> 3;
        const bf16* const Bs[2] = {(const bf16*)(ws + WS_WO) + (size_t)(64 * cg) * D, (const bf16*)(ws + WS_WO) + (size_t)(64 * cg + 32) * D};
        small_gemm<2>((const bf16*)(ws + WS_MG), D, Bs, rg, wave0, lds, [&](const float (&v)[2][2], int w, int r32, int hi) {
            float* SS = (float*)(ws + WS_SS1); bf16* HB = (bf16*)(ws + WS_H1B);
#pragma unroll
            for (int ii = 0; ii < 2; ++ii) { const int sr = 32 * rg + crow(2 * w + ii, hi), row = ROW_S0 + sr; float ss = 0.f;
#pragma unroll
                for (int nb = 0; nb < 2; ++nb) { const int col = 64 * cg + 32 * nb + r32; const float x = c.x_sample[(size_t)sr * D + col] + v[nb][ii];
                    HB[(size_t)row * D + col] = (bf16)f2bf(x); ss += x * x; }
                ss += __shfl_xor(ss, 1); ss += __shfl_xor(ss, 2); ss += __shfl_xor(ss, 4); ss += __shfl_xor(ss, 8); ss += __shfl_xor(ss, 16);
                if (r32 == 0) SS[(size_t)row * 16 + cg] = ss; } });
    }
    { pg8::Gemm g{(const pg8::bf16_t*)(ws + WS_MG), (const pg8::bf16_t*)(ws + WS_WO), ROW_S0, D, D}; pg8::StaticOrder S; S.init(ROW_S0, D, G, bx);
      EpiResid<0> E{c}; pg8::gemm_phase<EpiResid<0>, pg8::StaticOrder, true, true>(lds, g, S, E, wave0); }
    xcd_barrier(bar);
    for (int u = bx; u < 8 * (DFF / 32); u += G) {
        const int rg = u & 7, cg = u >> 3;
        const int wrow = ((32 * cg) >> 7) * 256 + ((32 * cg) & 127);
        const bf16* const Bs[2] = {(const bf16*)(ws + WS_WUP) + (size_t)wrow * D, (const bf16*)(ws + WS_WUP) + (size_t)(wrow + 128) * D};
        small_gemm<2>((const bf16*)(ws + WS_H1B), D, Bs, rg, wave0, lds, [&](const float (&v)[2][2], int w, int r32, int hi) {
            const float* SS = (const float*)(ws + WS_SS1); bf16* HID = (bf16*)(ws + WS_HID);
#pragma unroll
            for (int ii = 0; ii < 2; ++ii) { const int row = ROW_S0 + 32 * rg + crow(2 * w + ii, hi); const f32x4* sp = (const f32x4*)(SS + (size_t)row * 16);
                const f32x4 a = sp[0], b = sp[1], cc = sp[2], dd = sp[3];
                const float tot = ((a[0] + a[1]) + (a[2] + a[3])) + ((b[0] + b[1]) + (b[2] + b[3])) + ((cc[0] + cc[1]) + (cc[2] + cc[3])) + ((dd[0] + dd[1]) + (dd[2] + dd[3]));
                const float rstd = 1.f / sqrtf(tot * (1.f / D) + 1e-6f);
                HID[(size_t)row * DFF + 32 * cg + r32] = (bf16)f2bf(silu_f(v[0][ii] * rstd) * (v[1][ii] * rstd)); } });
    }
    { pg8::Gemm g{(const pg8::bf16_t*)(ws + WS_H1B), (const pg8::bf16_t*)(ws + WS_WUP), ROW_S0, 2 * DFF, D}; pg8::StaticOrder S; S.init(ROW_S0, 2 * DFF, G, bx);
      EpiUp E{c}; pg8::gemm_phase<EpiUp, pg8::StaticOrder, true, true>(lds, g, S, E, wave0); }
    xcd_barrier(bar);
    for (int u = bx; u < 128; u += G) {
        const int rg = u & 7, cg = u >> 3;
        const bf16* const Bs[2] = {(const bf16*)(ws + WS_WDN) + (size_t)(64 * cg) * DFF, (const bf16*)(ws + WS_WDN) + (size_t)(64 * cg + 32) * DFF};
        small_gemm<2>((const bf16*)(ws + WS_HID), DFF, Bs, rg, wave0, lds, [&](const float (&v)[2][2], int w, int r32, int hi) {
            float* SS = (float*)(ws + WS_SS2);
#pragma unroll
            for (int ii = 0; ii < 2; ++ii) { const int sr = 32 * rg + crow(2 * w + ii, hi), row = ROW_S0 + sr; float ss = 0.f;
#pragma unroll
                for (int nb = 0; nb < 2; ++nb) { const size_t idx = (size_t)row * D + 64 * cg + 32 * nb + r32; const float x = bf2f(((const bf16*)(ws + WS_H1B))[idx]) + v[nb][ii]; ((bf16*)(ws + WS_H2B))[idx] = (bf16)f2bf(x); ss += x * x; }
                ss += __shfl_xor(ss, 1); ss += __shfl_xor(ss, 2); ss += __shfl_xor(ss, 4); ss += __shfl_xor(ss, 8); ss += __shfl_xor(ss, 16);
                if (r32 == 0) SS[(size_t)row * 16 + cg] = ss; } });
    }
    { pg8::Gemm g{(const pg8::bf16_t*)(ws + WS_HID), (const pg8::bf16_t*)(ws + WS_WDN), ROW_S0, D, DFF}; pg8::StaticOrder S; S.init(ROW_S0, D, G, bx);
      EpiResid<1> E{c}; pg8::gemm_phase<EpiResid<1>, pg8::StaticOrder, true, true>(lds, g, S, E, wave0); }
    xcd_barrier(bar);
    { const int tid_ = fresh_tid(wave0); const int lane = tid_ & 63, wave = wave0;
      const int gw = vcu * 8 + wave, NGW = G * 8; const float* SS = (const float*)(ws + WS_SS2); const bf16* H2 = (const bf16*)(ws + WS_H2B);
      for (int m = gw; m < R_TAIL; m += NGW) { float* y = yrow(c, m);
          const float part = lane < 16 ? SS[(size_t)m * 16 + lane] : 0.f;
          const float rstd = 1.f / sqrtf(wave_sum(part) * (1.f / D) + 1e-6f);
          const u32x4* hr = (const u32x4*)(H2 + (size_t)m * D) + lane; f32x4* yr = (f32x4*)y; const f32x4* gr = (const f32x4*)c.nfg;
#pragma unroll
          for (int j = 0; j < 2; ++j) { float hf[8]; unpack8(__builtin_nontemporal_load(hr + 64 * j), hf); const int q = 2 * (64 * j + lane);
              const f32x4 g0 = gr[q], g1 = gr[q + 1];
              __builtin_nontemporal_store((f32x4){hf[0], hf[1], hf[2], hf[3]} * rstd * g0, yr + q); __builtin_nontemporal_store((f32x4){hf[4], hf[5], hf[6], hf[7]} * rstd * g1, yr + q + 1); } } }
}

extern "C" void kernel_launch(void* const* d_in, const int* in_sizes, int n_in, void* d_out, int out_size, void* d_ws, size_t ws_size, hipStream_t stream) {
    static int grid = 0;
    if (grid == 0) {
        if (n_in != 21 || ws_size < WS_END) { fprintf(stderr, "kernel_launch: unexpected n_in %d / ws_size %zu (need %zu)\n", n_in, ws_size, (size_t)WS_END); grid = -1; return; }
        int dev = 0, cus = 0, per_cu = 0;
        if (hipGetDevice(&dev) != hipSuccess || hipDeviceGetAttribute(&cus, hipDeviceAttributeMultiprocessorCount, dev) != hipSuccess) { grid = -1; return; }
        if (hipFuncSetAttribute((const void*)hybrid_fwd, hipFuncAttributeMaxDynamicSharedMemorySize, LDS_BYTES) != hipSuccess) { fprintf(stderr, "kernel_launch: hipFuncSetAttribute failed\n"); grid = -1; return; }
        if (hipOccupancyMaxActiveBlocksPerMultiprocessor(&per_cu, (const void*)hybrid_fwd, 512, LDS_BYTES) != hipSuccess || per_cu < 1) { fprintf(stderr, "kernel_launch: occupancy query says %d\n", per_cu); per_cu = 1; }
        (void)hipGetLastError();
        grid = cus * 1;
    }
    if (grid < 0) return;
    (void)hipMemsetAsync((char*)d_ws + WS_CTL, 0, CTL_BYTES, stream);
    Ctx c{};
    const float** f = (const float**)&c;
    for (int i = 0; i < 21; ++i) f[i] = (const float*)d_in[i];
    c.out = (float*)d_out; c.ws = (unsigned char*)d_ws;
    void* args[] = {&c};
    hipError_t e = hipLaunchCooperativeKernel((const void*)hybrid_fwd, dim3(grid), dim3(512), args, LDS_BYTES, stream);
    if (e != hipSuccess) fprintf(stderr, "kernel_launch: cooperative launch failed: %s (grid %d)\n", hipGetErrorString(e), grid);
}
```
